# Optimizing an MI355X kernel written in HIP

```python
import math
import jax, jax.numpy as jnp
from jax import lax
import numpy as np

D_MODEL = 1024
BATCH = 8
SEQ = 8192
DEPTH = 2
DEC_BATCH = 4
DEC_SEQ = 8192
PAST_LEN = 128

D_MIX = D_MODEL
RW_HEADS = 8
RW_HEAD = 64
RW_W = RW_HEADS * RW_HEAD
LORA_W = 64
LORA_A = 64
LORA_G = 128
RW_SPLITS = [RW_W, 2 * RW_W, 3 * RW_W, 3 * RW_W + 2 * LORA_W, 3 * RW_W + 2 * LORA_W + 2 * LORA_A]
RW_COLS = 3 * RW_W + 2 * LORA_W + 2 * LORA_A + LORA_G
DA_HEADS = 4
DA_HEAD = 64
DA_W = DA_HEADS * 2 * DA_HEAD
DA_COLS = 3 * DA_W
N_IN = RW_COLS + DA_COLS
D_FF = 2816
ROPE_THETA = 10000.0
Q_BLOCK = 128
LN_EPS = 1e-5
GN_EPS = 64e-5
SUBLN_EPS = 1e-5
ALPHA = (2.0 * DEPTH) ** 0.25
BETA = (8.0 * DEPTH) ** -0.25

kernel_name = "hymba_rwkv7_diffattn_macaron_deepnorm_encoder"


def layer_norm(x, g, b):
    xf = x.astype(jnp.float32)
    mu = jnp.mean(xf, axis=-1, keepdims=True)
    var = jnp.mean(jnp.square(xf - mu), axis=-1, keepdims=True)
    return ((xf - mu) * lax.rsqrt(var + LN_EPS) * g + b).astype(x.dtype)


def swiglu(x, w_gu, w_down):
    gate, up = jnp.split(x @ w_gu, 2, axis=-1)
    return (jax.nn.silu(gate) * up) @ w_down


def centred_token_shift(p, mu_prev, mu_next):
    prev = jnp.pad(p[:, :-1], ((0, 0), (1, 0), (0, 0)))
    nxt = jnp.pad(p[:, 1:], ((0, 0), (0, 1), (0, 0)))
    return p + mu_prev * (prev - p) + mu_next * (nxt - p)


def rwkv7_mixer(p, w_up, w_bias, a_up, a_bias, g_up, k_k, k_a, r_k, gn_g, gn_b):
    B, T, _ = p.shape
    H, N, C = RW_HEADS, RW_HEAD, RW_W
    f32 = jnp.float32
    r, k, v, wd, ad, gd = jnp.split(p, RW_SPLITS, axis=-1)
    wd = wd.reshape(B, T, 2, LORA_W)
    ad = ad.reshape(B, T, 2, LORA_A)
    w_logit = (w_bias + jnp.einsum('btdr,drc->btdc', jnp.tanh(wd), w_up)).astype(f32)
    decay = jnp.exp(-jnp.exp(-jax.nn.softplus(-w_logit) - 0.5))
    a = jax.nn.sigmoid((a_bias + jnp.einsum('btdr,drc->btdc', ad, a_up)).astype(f32))
    g = (jax.nn.sigmoid(gd) @ g_up).astype(f32)
    r = r.astype(f32)
    k = k.astype(f32)
    v = v.astype(f32)
    kk = (k * k_k).reshape(B, T, H, N)
    kk = kk * lax.rsqrt(jnp.maximum(jnp.sum(kk * kk, axis=-1, keepdims=True), 1e-24))
    kk = kk.reshape(B, T, C)
    k_mod = k[:, :, None] * (1.0 + (a - 1.0) * k_a)

    def dirs(z):
        z = jnp.stack([z[:, :, 0], jnp.flip(z[:, :, 1], axis=1)], axis=1)
        return z.reshape(B, 2, T, H, N).transpose(2, 1, 0, 3, 4)

    def both(z):
        return dirs(jnp.stack([z, z], axis=2))

    def step(S, inp):
        r_t, w_t, k_t, v_t, kk_t, a_t = inp
        sa = jnp.einsum('dbhij,dbhj->dbhi', S, -kk_t)
        S = (S * w_t[..., None, :] + sa[..., :, None] * (kk_t * a_t)[..., None, :]
             + v_t[..., :, None] * k_t[..., None, :])
        return S, jnp.einsum('dbhij,dbhj->dbhi', S, r_t)

    S0 = jnp.zeros((2, B, H, N, N), f32)
    _, o = lax.scan(step, S0, (both(r), dirs(decay), dirs(k_mod), both(v), both(kk), dirs(a)))
    o = o[:, 0] + jnp.flip(o[:, 1], axis=0)
    o = o.transpose(1, 0, 2, 3)
    mu = jnp.mean(o, axis=-1, keepdims=True)
    var = jnp.mean(jnp.square(o - mu), axis=-1, keepdims=True)
    o = ((o - mu) * lax.rsqrt(var + GN_EPS)).reshape(B, T, C) * gn_g + gn_b
    rk = jnp.sum((r * jnp.sum(k_mod, axis=2)).reshape(B, T, H, N) * r_k, axis=-1, keepdims=True)
    o = o + (rk * v.reshape(B, T, H, N)).reshape(B, T, C)
    return (o * g).astype(p.dtype)


def rope_tables(T, n):
    inv = jnp.power(ROPE_THETA, -jnp.arange(0, n, 2, dtype=jnp.float32) / n)
    ang = jnp.arange(T, dtype=jnp.float32)[:, None] * inv[None, :]
    ang = jnp.concatenate([ang, ang], axis=-1)
    return jnp.cos(ang), jnp.sin(ang)


def apply_rope(x, cos, sin):
    x1, x2 = jnp.split(x, 2, axis=-1)
    rot = jnp.concatenate([-x2, x1], axis=-1)
    return (x * cos + rot * sin).astype(x.dtype)


def diff_attention(p, lam, lam_init, subln_g):
    B, T, _ = p.shape
    H, N = DA_HEADS, DA_HEAD
    f32 = jnp.float32
    q, k, v = jnp.split(p, 3, axis=-1)
    q = q.reshape(B, T, H, 2, N)
    k = k.reshape(B, T, H, 2, N)
    v = v.reshape(B, T, H, 2 * N)
    cos, sin = rope_tables(T, N)
    cos = cos[:, None, None, :].astype(p.dtype)
    sin = sin[:, None, None, :].astype(p.dtype)
    q = apply_rope(q, cos, sin)
    k = apply_rope(k, cos, sin)
    scale = 1.0 / math.sqrt(N)
    nb = T // Q_BLOCK
    qb = q.reshape(B, nb, Q_BLOCK, H, 2, N).swapaxes(0, 1)

    def attend(q_blk):
        s = jnp.einsum('bqhcn,bkhcn->bhcqk', q_blk, k).astype(f32) * scale
        pr = jax.nn.softmax(s, axis=-1)
        pr = pr[:, :, 0] - lam * pr[:, :, 1]
        return jnp.einsum('bhqk,bkhv->bqhv', pr.astype(v.dtype), v)

    o = lax.map(attend, qb).swapaxes(0, 1).reshape(B, T, H, 2 * N).astype(f32)
    o = o * lax.rsqrt(jnp.mean(o * o, axis=-1, keepdims=True) + SUBLN_EPS) * subln_g
    o = o * (1.0 - lam_init)
    return o.reshape(B, T, DA_W).astype(p.dtype)


def encoder_layer(x, lam_init, ln_g, ln_b, ffn_w_gu, ffn_w_down, w_in, w_out, shift_mu,
                  rw_w_up, rw_w_bias, rw_a_up, rw_a_bias, rw_g_up, rw_k_k, rw_k_a, rw_r_k,
                  rw_gn_g, rw_gn_b, da_lambda, da_subln_g):
    x = layer_norm(ALPHA * x + 0.5 * swiglu(x, ffn_w_gu[0], ffn_w_down[0]), ln_g[0], ln_b[0])
    proj = x @ w_in
    p_rw = centred_token_shift(proj[..., :RW_COLS], shift_mu[0], shift_mu[1])
    p_da = proj[..., RW_COLS:]
    y_rw = rwkv7_mixer(p_rw, rw_w_up, rw_w_bias, rw_a_up, rw_a_bias, rw_g_up,
                       rw_k_k, rw_k_a, rw_r_k, rw_gn_g, rw_gn_b)
    lq1, lk1, lq2, lk2 = (da_lambda[i].astype(jnp.float32) for i in range(4))
    lam = jnp.exp(jnp.sum(lq1 * lk1)) - jnp.exp(jnp.sum(lq2 * lk2)) + lam_init
    y_da = diff_attention(p_da, lam, lam_init, da_subln_g)
    h = jnp.concatenate([y_rw, y_da], axis=-1) @ w_out
    x = layer_norm(ALPHA * x + h, ln_g[1], ln_b[1])
    x = layer_norm(ALPHA * x + 0.5 * swiglu(x, ffn_w_gu[1], ffn_w_down[1]), ln_g[2], ln_b[2])
    return x


def setup_inputs(seed: int = 0) -> dict:
    key = jax.random.key(seed)
    ks = jax.random.split(key, 21)
    f32 = jnp.float32

    def nrm(k, shape, s):
        return jax.random.normal(k, shape, f32) * s

    return {
        "x_prompt": nrm(ks[0], (BATCH, SEQ, D_MODEL), 1.0),
        "x_sample": nrm(ks[1], (DEC_BATCH, DEC_SEQ, D_MODEL), 1.0),
        "ln_g": 1.0 + nrm(ks[2], (DEPTH, 3, D_MODEL), 0.02),
        "ln_b": nrm(ks[3], (DEPTH, 3, D_MODEL), 0.02),
        "ffn_w_gu": nrm(ks[4], (DEPTH, 2, D_MODEL, 2 * D_FF), D_MODEL ** -0.5),
        "ffn_w_down": nrm(ks[5], (DEPTH, 2, D_FF, D_MODEL), BETA * D_FF ** -0.5),
        "w_in": nrm(ks[6], (DEPTH, D_MODEL, N_IN), D_MODEL ** -0.5),
        "w_out": nrm(ks[7], (DEPTH, D_MIX, D_MODEL), BETA * D_MIX ** -0.5),
        "shift_mu": jax.random.uniform(ks[8], (DEPTH, 2, RW_COLS), f32, 0.0, 0.5),
        "rw_w_up": nrm(ks[9], (DEPTH, 2, LORA_W, RW_W), 0.1),
        "rw_w_bias": jax.random.uniform(ks[10], (DEPTH, 2, RW_W), f32, -6.0, 1.0),
        "rw_a_up": nrm(ks[11], (DEPTH, 2, LORA_A, RW_W), 0.1),
        "rw_a_bias": nrm(ks[12], (DEPTH, 2, RW_W), 0.1),
        "rw_g_up": nrm(ks[13], (DEPTH, LORA_G, RW_W), LORA_G ** -0.5),
        "rw_k_k": 0.85 + nrm(ks[14], (DEPTH, RW_W), 0.02),
        "rw_k_a": 1.0 + nrm(ks[15], (DEPTH, RW_W), 0.02),
        "rw_r_k": nrm(ks[16], (DEPTH, RW_HEADS, RW_HEAD), 0.1),
        "rw_gn_g": 1.0 + nrm(ks[17], (DEPTH, RW_W), 0.02),
        "rw_gn_b": nrm(ks[18], (DEPTH, RW_W), 0.02),
        "da_lambda": nrm(ks[19], (DEPTH, 4, DA_HEAD), 0.1),
        "da_subln_g": 1.0 + nrm(ks[20], (DEPTH, 2 * DA_HEAD), 0.02),
    }


def reference(x_prompt, x_sample, ln_g, ln_b, ffn_w_gu, ffn_w_down, w_in, w_out, shift_mu,
              rw_w_up, rw_w_bias, rw_a_up, rw_a_bias, rw_g_up, rw_k_k, rw_k_a, rw_r_k,
              rw_gn_g, rw_gn_b, da_lambda, da_subln_g):
    def trunk(x):
        for l in range(DEPTH):
            lam_init = 0.8 - 0.6 * math.exp(-0.3 * l)
            x = encoder_layer(x, lam_init, ln_g[l], ln_b[l], ffn_w_gu[l], ffn_w_down[l],
                              w_in[l], w_out[l], shift_mu[l], rw_w_up[l], rw_w_bias[l],
                              rw_a_up[l], rw_a_bias[l], rw_g_up[l], rw_k_k[l], rw_k_a[l],
                              rw_r_k[l], rw_gn_g[l], rw_gn_b[l], da_lambda[l], da_subln_g[l])
        return x

    y_prompt = trunk(x_prompt)
    y_sample = trunk(x_sample)
    return (y_prompt, y_sample)
```

```cpp
#include <hip/hip_runtime.h>
#include <hip/hip_cooperative_groups.h>
#include <cstdio>
#include <cstdint>
#include <cmath>
namespace cg = cooperative_groups;
__device__ __forceinline__ int otid();

namespace pg8 {
#define PG8_LAS __attribute__((address_space(3)))
typedef unsigned short bf16_t;
typedef short bf16x8 __attribute__((ext_vector_type(8)));
typedef float f32x4 __attribute__((ext_vector_type(4)));
typedef unsigned u32x4 __attribute__((ext_vector_type(4)));
constexpr int BM = 256, BK = 64, HALF = 128, HTB = HALF * BK * 2  , STAGE_BYTES = 8 * HTB, NXCD = 8, WGM = 8;

__host__ __device__ __forceinline__ int lds_byte(int r, int c) { const int st = (r >> 4) * 2 + (c >> 5), rr = r & 15, cc = c & 31, ob = rr * 64 + cc * 2; return st * 1024 + (ob ^ (((ob >> 9) & 1) << 5)); }
__host__ __device__ __forceinline__ void stage_rc(int b, int& R, int& C) { const int st = b / 1024, sb = b % 1024, swz = sb ^ (((sb >> 9) & 1) << 5); R = (st >> 1) * 16 + swz / 64; C = (st & 1) * 32 + (swz % 64) / 2; }
__host__ __device__ __forceinline__ int perm32(int rho) { const int n = rho >> 4, i = rho & 15; return 8 * (i >> 2) + 4 * n + (i & 3); }

struct Unit { int pm, pn; };
struct Gemm { const bf16_t* A; const bf16_t* Bt; int M, N, K; };

struct StaticOrder {
    int nM, nN, nwg, G, c;
    __host__ __device__ void init(int M, int N, int G_, int c_) { nM = M / BM; nN = N / BM; nwg = nM * nN; G = G_; c = c_; }
    __host__ __device__ bool next(int i, Unit& u) const {
        const long L = (long)i * G + c; if (L >= nwg) return false;
        int wgid = (int)L; { const int q = nwg / NXCD, r = nwg % NXCD, xcd = wgid % NXCD, off = wgid / NXCD; wgid = (xcd < r ? xcd * (q + 1) : r * (q + 1) + (xcd - r) * q) + off; }
        const int nig = WGM * nN, gid = wgid / nig, fm = gid * WGM, gsz = (nM - fm) < WGM ? (nM - fm) : WGM;
        u.pm = fm + ((wgid % nig) % gsz); u.pn = (wgid % nig) / gsz; return true;
    }
    __device__ __forceinline__ void a_ready(const Unit&) const {}
    __device__ __forceinline__ void done(const Unit&) const {}
};
__device__ __forceinline__ unsigned cvt_pk_bf16(float lo, float hi) { unsigned r; asm volatile("v_cvt_pk_bf16_f32 %0, %1, %2" : "=v"(r) : "v"(lo), "v"(hi)); return r; }

template <class Epi, class Sched, bool STAMP = false>
__device__ __forceinline__ void gemm_phase(PG8_LAS unsigned char* lds, const Gemm g, const Sched& S, const Epi& E, unsigned long long* stamps) {
    const int tid = otid(), wid = __builtin_amdgcn_readfirstlane(tid >> 6), lane = tid & 63, wr = wid >> 2, wc = wid & 3, fr = lane & 15, fq = lane >> 4;
    const int K = g.K, nt = K / BK;
    int ts_lo = 0, ts_hi = 0, nts = 0; const unsigned long long rt_entry = STAMP ? (unsigned long long)wall_clock64() : 0ull;
#define PG8_STAMP() do { if (STAMP && wid == 0 && nts < 64) { const unsigned long long _c = (unsigned long long)clock64(); \
        ts_lo = (lane == nts) ? (int)(unsigned)_c : ts_lo; ts_hi = (lane == nts) ? (int)(unsigned)(_c >> 32) : ts_hi; ++nts; } } while (0)
    PG8_STAMP();
    unsigned voffA[2], voffB[2];
#pragma unroll
    for (int i = 0; i < 2; ++i) { int R, C; stage_rc(tid * 16 + i * 8192, R, C); const int Rb = Epi::PERM ? ((R & ~31) + perm32(R & 31)) : R;
        voffA[i] = (unsigned)(R * K + C) * 2u; voffB[i] = (unsigned)(Rb * K + C) * 2u; }
    const size_t kstep = (size_t)(BK * 2);
    const size_t hstep = (size_t)HALF * K * 2;
    const size_t tstep = 2 * hstep;
    const unsigned ldsw = (unsigned)wid * 1024u;
    const int aoff = lds_byte(wr * 64 + fr, fq * 8), boff = lds_byte(wc * 32 + fr, fq * 8);
#define PG8_SA(b, h) (((b) * 2 + (h)) * HTB)
#define PG8_SB(b, h) ((4 + (b) * 2 + (h)) * HTB)
#define PG8_STAGE(bufoff, gbase, voff) do { _Pragma("unroll") for (int _i = 0; _i < 2; ++_i) \
        __builtin_amdgcn_global_load_lds((const unsigned*)((const char*)(gbase) + (voff)[_i]), (PG8_LAS unsigned*)(lds + (bufoff) + ldsw + _i * 8192), 16, 0, 0); } while (0)
#define PG8_LDA(dst, b, h) do { _Pragma("unroll") for (int m = 0; m < 4; ++m) _Pragma("unroll") for (int k = 0; k < 2; ++k) dst[m][k] = *(const PG8_LAS bf16x8*)(lds + PG8_SA(b, h) + aoff + m * 2048 + k * 1024); } while (0)
#define PG8_LDB(dst, b, h) do { _Pragma("unroll") for (int n = 0; n < 2; ++n) _Pragma("unroll") for (int k = 0; k < 2; ++k) dst[n][k] = *(const PG8_LAS bf16x8*)(lds + PG8_SB(b, h) + boff + n * 2048 + k * 1024); } while (0)
#define PG8_MMA(ai, bj, At, Bt) do { __builtin_amdgcn_s_setprio(1); _Pragma("unroll") for (int m = 0; m < 4; ++m) _Pragma("unroll") for (int n = 0; n < 2; ++n) _Pragma("unroll") for (int k = 0; k < 2; ++k) \
        acc[ai][bj][m][n] = __builtin_amdgcn_mfma_f32_16x16x32_bf16(Bt[n][k], At[m][k], acc[ai][bj][m][n], 0, 0, 0); __builtin_amdgcn_s_setprio(0); } while (0)
#define PG8_WAIT_V(n) asm volatile("s_waitcnt vmcnt(" #n ")" ::: "memory")
#define PG8_WAIT_L(n) asm volatile("s_waitcnt lgkmcnt(" #n ")" ::: "memory")
#define PG8_BAR __builtin_amdgcn_s_barrier()
#define PG8_SCHED __builtin_amdgcn_sched_barrier(0)
    Unit cur, nxt; int ui = 0;
    if (!S.next(0, cur)) return;
    f32x4 acc[2][2][4][2];
#pragma unroll
    for (int a = 0; a < 2; ++a)
#pragma unroll
        for (int b = 0; b < 2; ++b)
#pragma unroll
            for (int m = 0; m < 4; ++m)
#pragma unroll
                for (int n = 0; n < 2; ++n) acc[a][b][m][n] = (f32x4){0.f, 0.f, 0.f, 0.f};
    bf16x8 At[4][2], B0[2][2], B1[2][2];
    const char* cA = (const char*)g.A + (size_t)cur.pm * tstep; const char* cB = (const char*)g.Bt + (size_t)cur.pn * tstep;
    S.a_ready(cur);
    PG8_STAGE(PG8_SB(0, 0), cB, voffB); PG8_STAGE(PG8_SA(0, 0), cA, voffA); PG8_STAGE(PG8_SB(0, 1), cB + hstep, voffB); PG8_STAGE(PG8_SA(0, 1), cA + hstep, voffA);
    if (wr == 1) PG8_BAR;
    PG8_WAIT_V(4); PG8_BAR;
    PG8_STAGE(PG8_SB(1, 0), cB + kstep, voffB); PG8_STAGE(PG8_SA(1, 0), cA + kstep, voffA); PG8_STAGE(PG8_SB(1, 1), cB + hstep + kstep, voffB);
    PG8_WAIT_V(6); PG8_BAR;
    PG8_STAMP();
    for (;;) {
        const bool has_next = S.next(ui + 1, nxt);
        const char* nA = has_next ? (const char*)g.A + (size_t)nxt.pm * tstep : cA; const char* nB = has_next ? (const char*)g.Bt + (size_t)nxt.pn * tstep : cB;
        for (int t = 0; t < nt; t += 2) {
            const bool last = (t == nt - 2);
            const char* a1 = cA + (size_t)(t + 1) * kstep;
            const char* a2 = last ? nA : cA + (size_t)(t + 2) * kstep; const char* b2 = last ? nB : cB + (size_t)(t + 2) * kstep;
            const char* a3 = a2 + kstep; const char* b3 = b2 + kstep;
            if (last && has_next) S.a_ready(nxt);
            PG8_LDB(B0, 0, 0); PG8_SCHED; PG8_LDA(At, 0, 0); PG8_STAGE(PG8_SA(1, 1), a1 + hstep, voffA);
            PG8_WAIT_L(8); PG8_BAR; PG8_WAIT_L(0); PG8_MMA(0, 0, At, B0); PG8_BAR; PG8_SCHED;
            PG8_LDB(B1, 0, 1); PG8_STAGE(PG8_SB(0, 0), b2, voffB);
            PG8_BAR; PG8_WAIT_L(0); PG8_MMA(0, 1, At, B1); PG8_BAR;
            PG8_LDA(At, 0, 1); PG8_STAGE(PG8_SA(0, 0), a2, voffA);
            PG8_BAR; PG8_WAIT_L(0); PG8_MMA(1, 0, At, B0); PG8_BAR; PG8_SCHED;
            PG8_STAGE(PG8_SB(0, 1), b2 + hstep, voffB);
            PG8_WAIT_V(6); PG8_BAR; PG8_MMA(1, 1, At, B1); PG8_BAR;
            PG8_LDB(B0, 1, 0); PG8_SCHED; PG8_LDA(At, 1, 0); PG8_STAGE(PG8_SA(0, 1), a2 + hstep, voffA);
            PG8_WAIT_L(8); PG8_BAR; PG8_WAIT_L(0); PG8_MMA(0, 0, At, B0); PG8_BAR; PG8_SCHED;
            PG8_LDB(B1, 1, 1); PG8_STAGE(PG8_SB(1, 0), b3, voffB);
            PG8_BAR; PG8_WAIT_L(0); PG8_MMA(0, 1, At, B1); PG8_BAR;
            PG8_LDA(At, 1, 1); PG8_STAGE(PG8_SA(1, 0), a3, voffA);
            PG8_BAR; PG8_WAIT_L(0); PG8_MMA(1, 0, At, B0); PG8_BAR; PG8_SCHED;
            PG8_STAGE(PG8_SB(1, 1), b3 + hstep, voffB);
            PG8_WAIT_V(6); PG8_BAR; PG8_MMA(1, 1, At, B1); PG8_BAR;
        }
        PG8_STAMP();
        if constexpr (!Epi::AFTER_DRAIN) { E(acc, cur, wr, wc, fr, fq); S.done(cur); }
        PG8_STAMP();
        if (!has_next) break;
#pragma unroll
        for (int a = 0; a < 2; ++a)
#pragma unroll
            for (int b = 0; b < 2; ++b)
#pragma unroll
                for (int m = 0; m < 4; ++m)
#pragma unroll
                    for (int n = 0; n < 2; ++n) acc[a][b][m][n] = (f32x4){0.f, 0.f, 0.f, 0.f};
        cur = nxt; cA = nA; cB = nB; ++ui;
    }
    PG8_WAIT_V(0);
    if (wr == 0) PG8_BAR;
    PG8_BAR;
    if constexpr (Epi::AFTER_DRAIN) { E.fused(acc, cur, wr, wc, fr, fq, lds, wid, lane); S.done(cur); }
    PG8_STAMP();
    if (STAMP && wid == 0) { stamps[lane] = lane < nts ? (((unsigned long long)(unsigned)ts_hi << 32) | (unsigned)ts_lo) : 0ull;
        if (lane == 62) stamps[62] = rt_entry; if (lane == 63) stamps[63] = (unsigned long long)wall_clock64(); }
#undef PG8_STAMP
#undef PG8_SA
#undef PG8_SB
#undef PG8_STAGE
#undef PG8_LDA
#undef PG8_LDB
#undef PG8_MMA
#undef PG8_WAIT_V
#undef PG8_WAIT_L
#undef PG8_BAR
#undef PG8_SCHED
}
}

typedef unsigned short u16;
using pg8::bf16x8; using pg8::f32x4; using pg8::u32x4;
typedef short s16x4 __attribute__((ext_vector_type(4)));
typedef float f32x16 __attribute__((ext_vector_type(16)));
typedef unsigned u32x2 __attribute__((ext_vector_type(2)));

constexpr int DM = 1024, TSEQ = 8192, NSEQ = 12, NT = NSEQ * TSEQ, DEPTH_ = 2;
constexpr int DFF = 2816, NGU = 2 * DFF, NIN = 3456, NINP = 3584, RWC = 1920, DAC = 1536;
constexpr float ALPHA_ = 1.4142135623730951f;
constexpr float LN_EPS_ = 1e-5f, GN_EPS_ = 64e-5f, SUBLN_EPS_ = 1e-5f;
constexpr int LDS_BYTES = 131072;

constexpr size_t WS_WGU = 0;
constexpr size_t WS_WDN = WS_WGU + (size_t)2 * 2 * NGU * DM * 2;
constexpr size_t WS_WIN = WS_WDN + (size_t)2 * 2 * DM * DFF * 2;
constexpr size_t WS_WOUT = WS_WIN + (size_t)2 * NINP * DM * 2;
constexpr size_t WS_WUP = WS_WOUT + (size_t)2 * DM * DM * 2;
constexpr size_t WS_AUP = WS_WUP + (size_t)2 * 2 * 512 * 64 * 2;
constexpr size_t WS_GUP = WS_AUP + (size_t)2 * 2 * 512 * 64 * 2;
constexpr size_t WS_ROPE = WS_GUP + (size_t)2 * 512 * 128 * 2;
constexpr size_t WS_RK = WS_ROPE + (size_t)TSEQ * 32 * 2 * 4;
constexpr size_t WS_SCR = WS_RK + (size_t)2 * NT * 8 * 4;
constexpr size_t WS_XB = WS_SCR + (size_t)256 * 256 * 128 * 4;
constexpr size_t WS_BIG = WS_XB + (size_t)NT * DM * 2;
constexpr size_t WS_PRW = WS_BIG;
constexpr size_t WS_PDA = WS_PRW + (size_t)NT * RWC * 2;
constexpr size_t WS_END = WS_PDA + (size_t)NT * DAC * 2;
static_assert(WS_BIG + (size_t)NT * DFF * 2 <= WS_END, "H fits");
static_assert(WS_END <= (size_t)1073741824, "workspace budget");

struct Params {
    const float* in[21];
    float* out;
    unsigned char* ws;
    float inv[32];
};

typedef const __attribute__((address_space(4))) Params* KP;
__device__ __forceinline__ KP launder_kp(KP p) { asm volatile("" : "+s"(p)); return p; }
__device__ __forceinline__ int otid() { int t = threadIdx.x; asm volatile("" : "+v"(t)); return t; }
__device__ __forceinline__ float bf2f(u16 b) { return __uint_as_float(((unsigned)b) << 16); }
__device__ __forceinline__ float bflo(unsigned w) { return __uint_as_float(w << 16); }
__device__ __forceinline__ float bfhi(unsigned w) { return __uint_as_float(w & 0xffff0000u); }
__device__ __forceinline__ unsigned cvtpk(float lo, float hi) { return pg8::cvt_pk_bf16(lo, hi); }
__device__ __forceinline__ u16 f2bf(float x) { return (u16)(cvtpk(x, 0.f) & 0xffffu); }
__device__ __forceinline__ void unpack8(const u32x4 w, float* f) {
    f[0] = bflo(w[0]); f[1] = bfhi(w[0]); f[2] = bflo(w[1]); f[3] = bfhi(w[1]); f[4] = bflo(w[2]); f[5] = bfhi(w[2]); f[6] = bflo(w[3]); f[7] = bfhi(w[3]);
}
__device__ __forceinline__ u32x4 pack8(const float* f) { u32x4 w = {cvtpk(f[0], f[1]), cvtpk(f[2], f[3]), cvtpk(f[4], f[5]), cvtpk(f[6], f[7])}; return w; }
__device__ __forceinline__ int crow(int r, int hi) { return (r & 3) + 8 * (r >> 2) + 4 * hi; }
__device__ __forceinline__ float sigmoidf_(float x) { return 1.f / (1.f + __expf(-x)); }

struct EpiSwiglu {
    static constexpr bool PERM = true, AFTER_DRAIN = false;
    u16* H;
    __device__ __forceinline__ void operator()(const f32x4 (&acc)[2][2][4][2], const pg8::Unit& u, int wr, int wc, int fr, int fq) const {
        const int row0 = u.pm * 256 + wr * 64 + fr, col0 = u.pn * 128 + wc * 32 + 8 * fq;
#pragma unroll
        for (int ai = 0; ai < 2; ++ai)
#pragma unroll
            for (int m = 0; m < 4; ++m) {
                float o[8];
#pragma unroll
                for (int n = 0; n < 2; ++n)
#pragma unroll
                    for (int e = 0; e < 4; ++e) { const float g = acc[ai][0][m][n][e], up = acc[ai][1][m][n][e]; o[n * 4 + e] = g / (1.f + __expf(-g)) * up; }
                *(u32x4*)(H + (size_t)(row0 + ai * 128 + m * 16) * DFF + col0) = pack8(o);
            }
    }
};
struct EpiResid {
    static constexpr bool PERM = false, AFTER_DRAIN = false;
    float* X; float scale;
    __device__ __forceinline__ void operator()(const f32x4 (&acc)[2][2][4][2], const pg8::Unit& u, int wr, int wc, int fr, int fq) const {
        const int row0 = u.pm * 256 + wr * 64 + fr, col0 = u.pn * 256 + wc * 32 + 4 * fq;
#pragma unroll
        for (int ai = 0; ai < 2; ++ai)
#pragma unroll
            for (int m = 0; m < 4; ++m) { float* rowp = X + (size_t)(row0 + ai * 128 + m * 16) * DM + col0;
#pragma unroll
                for (int bj = 0; bj < 2; ++bj)
#pragma unroll
                    for (int n = 0; n < 2; ++n) { f32x4* p = (f32x4*)(rowp + bj * 128 + n * 16); const f32x4 x = *p; *p = x * ALPHA_ + acc[ai][bj][m][n] * scale; } }
    }
};
struct EpiProj {
    static constexpr bool PERM = true, AFTER_DRAIN = false;
    u16* PRW; u16* PDA;
    __device__ __forceinline__ void operator()(const f32x4 (&acc)[2][2][4][2], const pg8::Unit& u, int wr, int wc, int fr, int fq) const {
        const int row0 = u.pm * 256 + wr * 64 + fr;
#pragma unroll
        for (int bj = 0; bj < 2; ++bj) {
            const int cb = u.pn * 256 + bj * 128;
            u16* base; int ld;
            if (cb < RWC) { base = PRW + cb; ld = RWC; } else if (cb < NIN) { base = PDA + (cb - RWC); ld = DAC; } else continue;
            base += wc * 32 + 8 * fq;
#pragma unroll
            for (int ai = 0; ai < 2; ++ai)
#pragma unroll
                for (int m = 0; m < 4; ++m) {
                    float o[8];
#pragma unroll
                    for (int n = 0; n < 2; ++n)
#pragma unroll
                        for (int e = 0; e < 4; ++e) o[n * 4 + e] = acc[ai][bj][m][n][e];
                    *(u32x4*)(base + (size_t)(row0 + ai * 128 + m * 16) * ld) = pack8(o);
                }
        }
    }
};

template <class Epi>
__device__ __forceinline__ void run_gemm(unsigned char* shm, const u16* A, const u16* Bt, int N, int K, const Epi& E) {
    pg8::Gemm g; g.A = A; g.Bt = Bt; g.M = NT; g.N = N; g.K = K;
    pg8::StaticOrder S; S.init(NT, N, (int)gridDim.x, (int)blockIdx.x);
    pg8::gemm_phase<Epi, pg8::StaticOrder, false>((PG8_LAS unsigned char*)shm, g, S, E, nullptr);
}

template <int MAP>
__device__ __forceinline__ void tr_job(const float* __restrict__ src, int K, int ld, u16* __restrict__ dst, int Ndst, float* tile) {
    const int tid = otid(), ntk = K / 64, ntn = Ndst / 64;
    for (int ti = blockIdx.x; ti < ntk * ntn; ti += gridDim.x) {
        const int tn = ti / ntk, tk = ti % ntk, n0 = tn * 64, k0 = tk * 64;
        int sc0 = n0; bool zero = false;
        if (MAP == 1) { const int pn = n0 >> 8, bj = (n0 >> 7) & 1, c = n0 & 127; sc0 = bj * DFF + pn * 128 + c; }
        if (MAP == 2) zero = n0 >= NIN;
        const int c4 = (tid & 15) * 4;
#pragma unroll
        for (int p = 0; p < 2; ++p) { const int kr = (tid >> 4) + p * 32;
            f32x4 v = {0.f, 0.f, 0.f, 0.f}; if (!zero) v = *(const f32x4*)(src + (size_t)(k0 + kr) * ld + sc0 + c4);
            tile[kr * 65 + c4 + 0] = v[0]; tile[kr * 65 + c4 + 1] = v[1]; tile[kr * 65 + c4 + 2] = v[2]; tile[kr * 65 + c4 + 3] = v[3]; }
        __syncthreads();
        { const int nr = tid >> 3, kc = (tid & 7) * 8; float f[8];
#pragma unroll
          for (int e = 0; e < 8; ++e) f[e] = tile[(kc + e) * 65 + nr];
          *(u32x4*)(dst + (size_t)(n0 + nr) * K + k0 + kc) = pack8(f); }
        __syncthreads();
    }
}

__device__ __forceinline__ void phase0(KP P, unsigned char* shm) {
    float* tile = (float*)shm; unsigned char* ws = P->ws;
    for (int i = 0; i < 4; ++i) {
        tr_job<1>(P->in[4] + (size_t)i * DM * NGU, DM, NGU, (u16*)(ws + WS_WGU) + (size_t)i * NGU * DM, NGU, tile);
        tr_job<0>(P->in[5] + (size_t)i * DFF * DM, DFF, DM, (u16*)(ws + WS_WDN) + (size_t)i * DM * DFF, DM, tile);
        tr_job<0>(P->in[9] + (size_t)i * 64 * 512, 64, 512, (u16*)(ws + WS_WUP) + (size_t)i * 512 * 64, 512, tile);
        tr_job<0>(P->in[11] + (size_t)i * 64 * 512, 64, 512, (u16*)(ws + WS_AUP) + (size_t)i * 512 * 64, 512, tile);
    }
    for (int l = 0; l < 2; ++l) {
        tr_job<2>(P->in[6] + (size_t)l * DM * NIN, DM, NIN, (u16*)(ws + WS_WIN) + (size_t)l * NINP * DM, NINP, tile);
        tr_job<0>(P->in[7] + (size_t)l * DM * DM, DM, DM, (u16*)(ws + WS_WOUT) + (size_t)l * DM * DM, DM, tile);
        tr_job<0>(P->in[13] + (size_t)l * 128 * 512, 128, 512, (u16*)(ws + WS_GUP) + (size_t)l * 512 * 128, 512, tile);
    }
    const size_t gt = (size_t)blockIdx.x * 512 + otid(), gn = (size_t)gridDim.x * 512;
    { const size_t n4 = (size_t)NT * DM / 4, np4 = (size_t)8 * TSEQ * DM / 4;
      const f32x4* xp = (const f32x4*)P->in[0]; const f32x4* xs = (const f32x4*)P->in[1]; f32x4* xo = (f32x4*)P->out; u32x2* xb = (u32x2*)(ws + WS_XB);
      for (size_t i = gt; i < n4; i += gn) { const f32x4 v = i < np4 ? xp[i] : xs[i - np4]; xo[i] = v; u32x2 w = {cvtpk(v[0], v[1]), cvtpk(v[2], v[3])}; xb[i] = w; } }
    { float* rt = (float*)(ws + WS_ROPE);
      for (size_t idx = gt; idx < (size_t)TSEQ * 32; idx += gn) {
          const int t = (int)(idx >> 5), i = (int)(idx & 31);
          const float angf = (float)t * P->inv[i];
          const double x = (double)angf, n = rint(x * 0.63661977236758134308), r = fma(-n, 6.123233995736766e-17, fma(-n, 1.5707963267948966, x));
          const int q = ((int)n) & 3; const double r2 = r * r;
          double sn = r2 * (1.0 / 6227020800.0) - (1.0 / 39916800.0); sn = sn * r2 + (1.0 / 362880.0); sn = sn * r2 - (1.0 / 5040.0); sn = sn * r2 + (1.0 / 120.0); sn = sn * r2 - (1.0 / 6.0); sn = sn * r2 * r + r;
          double cs = r2 * (-1.0 / 87178291200.0) + (1.0 / 479001600.0); cs = cs * r2 - (1.0 / 3628800.0); cs = cs * r2 + (1.0 / 40320.0); cs = cs * r2 - (1.0 / 720.0); cs = cs * r2 + (1.0 / 24.0); cs = cs * r2 - 0.5; cs = cs * r2 + 1.0;
          double s_, c_; if (q == 0) { s_ = sn; c_ = cs; } else if (q == 1) { s_ = cs; c_ = -sn; } else if (q == 2) { s_ = -sn; c_ = -cs; } else { s_ = -cs; c_ = sn; }
          rt[idx * 2 + 0] = (float)c_; rt[idx * 2 + 1] = (float)s_;
      } }
}

__device__ __forceinline__ float wave_sum(float x) {
#pragma unroll
    for (int o = 32; o >= 1; o >>= 1) x += __shfl_xor(x, o);
    return x;
}
__device__ __forceinline__ void ln_phase(float* X, u16* Xb, const float* __restrict__ g, const float* __restrict__ b) {
    const int tid_ = otid(), wid = tid_ >> 6, lane = tid_ & 63;
    f32x4 gv[4], bv[4];
#pragma unroll
    for (int j = 0; j < 4; ++j) { gv[j] = *(const f32x4*)(g + j * 256 + lane * 4); bv[j] = *(const f32x4*)(b + j * 256 + lane * 4); }
    for (int row = blockIdx.x * 8 + wid; row < NT; row += gridDim.x * 8) {
        float* xr = X + (size_t)row * DM; f32x4 v[4]; float s = 0.f;
#pragma unroll
        for (int j = 0; j < 4; ++j) { v[j] = *(const f32x4*)(xr + j * 256 + lane * 4); s += v[j][0] + v[j][1] + v[j][2] + v[j][3]; }
        const float mu = wave_sum(s) * (1.f / DM); float q = 0.f;
#pragma unroll
        for (int j = 0; j < 4; ++j) { v[j] = v[j] - mu; q += v[j][0] * v[j][0] + v[j][1] * v[j][1] + v[j][2] * v[j][2] + v[j][3] * v[j][3]; }
        const float rs = 1.0f / sqrtf(wave_sum(q) * (1.f / DM) + LN_EPS_);
#pragma unroll
        for (int j = 0; j < 4; ++j) { const f32x4 y = v[j] * rs * gv[j] + bv[j]; *(f32x4*)(xr + j * 256 + lane * 4) = y;
            u32x2 w = {cvtpk(y[0], y[1]), cvtpk(y[2], y[3])}; *(u32x2*)(Xb + (size_t)row * DM + j * 256 + lane * 4) = w; }
    }
}

__device__ __forceinline__ void rope_phase(u16* PDA, const float* __restrict__ rt) {
    const size_t total = (size_t)NT * 64;
    for (size_t i = (size_t)blockIdx.x * 512 + otid(); i < total; i += (size_t)gridDim.x * 512) {
        const int token = (int)(i >> 6), sub = (int)(i & 63), vec = sub >> 2, f0 = (sub & 3) * 8, pos = token & (TSEQ - 1);
        u16* p = PDA + (size_t)token * DAC + vec * 64 + f0;
        const u32x4 w1 = *(const u32x4*)p, w2 = *(const u32x4*)(p + 32);
        float x1[8], x2[8], o1[8], o2[8]; unpack8(w1, x1); unpack8(w2, x2);
        const float* cs = rt + ((size_t)pos * 32 + f0) * 2;
#pragma unroll
        for (int e = 0; e < 8; ++e) { const float c = cs[2 * e], s = cs[2 * e + 1]; o1[e] = x1[e] * c - x2[e] * s; o2[e] = x2[e] * c + x1[e] * s; }
        *(u32x4*)p = pack8(o1); *(u32x4*)(p + 32) = pack8(o2);
    }
}

namespace att {
constexpr int NW = 8, QBLK = 32, KVBLK = 64, LDQ = DAC;
constexpr float SCALE = 0.125f, THR = 8.f;
constexpr int SHM_V = KVBLK * 128 * 2, SHM_K = KVBLK * 64 * 2;
#define KSWZ(row, colB) ((row) * 128 + ((colB) ^ ((((row) >> 1) & 7) << 4)))
#define SBAR() __builtin_amdgcn_sched_barrier(0)
__device__ __forceinline__ void partialSM(f32x16& p0, f32x16& p1, float& m_reg, float& mn, float& alpha) {
    constexpr float C = SCALE * 1.4426950408889634f;
    float pmax = p0[0];
#pragma unroll
    for (int r = 1; r < 16; ++r) pmax = fmaxf(pmax, p0[r]);
#pragma unroll
    for (int r = 0; r < 16; ++r) pmax = fmaxf(pmax, p1[r]);
    { auto rr = __builtin_amdgcn_permlane32_swap(__float_as_uint(pmax), __float_as_uint(pmax), false, false);
      pmax = fmaxf(__uint_as_float(rr[0]), __uint_as_float(rr[1])); }
    if (__builtin_expect(__all(pmax - m_reg <= THR / SCALE), 1)) { mn = m_reg; alpha = 1.f; }
    else { mn = fmaxf(m_reg, pmax); alpha = __builtin_amdgcn_exp2f((m_reg - mn) * C); m_reg = mn; }
    const float mnC = -mn * C;
#pragma unroll
    for (int r = 0; r < 16; ++r) p0[r] = fmaf(p0[r], C, mnC);
#pragma unroll
    for (int r = 0; r < 16; ++r) p1[r] = fmaf(p1[r], C, mnC);
#pragma unroll
    for (int r = 0; r < 16; ++r) p0[r] = __builtin_amdgcn_exp2f(p0[r]);
}
__device__ __forceinline__ void finishSM(f32x16& p0, f32x16& p1, float alpha, float& l_reg, bf16x8& pa0, bf16x8& pa1, bf16x8& pa2, bf16x8& pa3) {
#pragma unroll
    for (int r = 0; r < 16; ++r) p1[r] = __builtin_amdgcn_exp2f(p1[r]);
    float ps = 0;
#pragma unroll
    for (int r = 0; r < 16; ++r) ps += p0[r];
#pragma unroll
    for (int r = 0; r < 16; ++r) ps += p1[r];
    { auto rr = __builtin_amdgcn_permlane32_swap(__float_as_uint(ps), __float_as_uint(ps), false, false);
      ps = __uint_as_float(rr[0]) + __uint_as_float(rr[1]); }
    l_reg = l_reg * alpha + ps;
#define PK4(P, BASE, OUT) do { unsigned a0 = cvtpk(P[BASE + 0], P[BASE + 1]), a1 = cvtpk(P[BASE + 2], P[BASE + 3]);   \
    unsigned b0 = cvtpk(P[BASE + 4], P[BASE + 5]), b1 = cvtpk(P[BASE + 6], P[BASE + 7]);                              \
    auto r0 = __builtin_amdgcn_permlane32_swap(a0, b0, false, false); auto r1 = __builtin_amdgcn_permlane32_swap(a1, b1, false, false); \
    u32x4 w = {r0[0], r1[0], r0[1], r1[1]}; OUT = *reinterpret_cast<bf16x8*>(&w); } while (0)
    PK4(p0, 0, pa0); PK4(p0, 8, pa1); PK4(p1, 0, pa2); PK4(p1, 8, pa3);
#undef PK4
}
__device__ __forceinline__ void qkt(f32x16& p0, f32x16& p1, const char* Ks, const bf16x8* qr, int r32, int hi) {
    p0 = f32x16{}; p1 = f32x16{};
#pragma unroll
    for (int d0 = 0; d0 < 4; ++d0) { const int cb = (d0 * 16 + hi * 8) * 2;
        const bf16x8 b0 = *reinterpret_cast<const bf16x8*>(Ks + KSWZ(r32, cb));
        const bf16x8 b1 = *reinterpret_cast<const bf16x8*>(Ks + KSWZ(32 + r32, cb));
        p0 = __builtin_amdgcn_mfma_f32_32x32x16_bf16(b0, qr[d0], p0, 0, 0, 0);
        p1 = __builtin_amdgcn_mfma_f32_32x32x16_bf16(b1, qr[d0], p1, 0, 0, 0); }
}
__device__ __forceinline__ int v_st(int k, int c) { const int kk = (k & ~0xC) | ((k & 4) << 1) | ((k & 8) >> 1); return ((kk >> 3) * 4 + (c >> 5)) * 512 + ((kk & 7) * 32 + (c & 31)) * 2; }
__device__ __forceinline__ int v_rd_base(int lane) { return ((lane & 3) << 3) | (((lane >> 2) & 3) << 6) | (((lane >> 4) & 1) << 5) | (((lane >> 5) & 1) << 8); }
constexpr int v_rd_off(int d0, int ks, int half) { return d0 * 512 + ks * 4096 + half * 2048; }
template <int OFF> __device__ __forceinline__ s16x4 tr_read(int vb) {
    s16x4 r; asm volatile("ds_read_b64_tr_b16 %0, %1 offset:%2" : "=&v"(r) : "v"(vb), "i"(OFF) : "memory"); return r;
}
template <int D0> __device__ __forceinline__ void pv_one(f32x16& od, int vb, bf16x8 pa0, bf16x8 pa1, bf16x8 pa2, bf16x8 pa3) {
    const s16x4 l0 = tr_read<v_rd_off(D0, 0, 0)>(vb), h0 = tr_read<v_rd_off(D0, 0, 1)>(vb), l1 = tr_read<v_rd_off(D0, 1, 0)>(vb), h1 = tr_read<v_rd_off(D0, 1, 1)>(vb);
    const s16x4 l2 = tr_read<v_rd_off(D0, 2, 0)>(vb), h2 = tr_read<v_rd_off(D0, 2, 1)>(vb), l3 = tr_read<v_rd_off(D0, 3, 0)>(vb), h3 = tr_read<v_rd_off(D0, 3, 1)>(vb);
    asm volatile("s_waitcnt lgkmcnt(0)" ::: "memory"); SBAR();
#define PK(L, H) (bf16x8){L[0], L[1], L[2], L[3], H[0], H[1], H[2], H[3]}
    od = __builtin_amdgcn_mfma_f32_32x32x16_bf16(pa0, PK(l0, h0), od, 0, 0, 0);
    od = __builtin_amdgcn_mfma_f32_32x32x16_bf16(pa1, PK(l1, h1), od, 0, 0, 0);
    od = __builtin_amdgcn_mfma_f32_32x32x16_bf16(pa2, PK(l2, h2), od, 0, 0, 0);
    od = __builtin_amdgcn_mfma_f32_32x32x16_bf16(pa3, PK(l3, h3), od, 0, 0, 0);
#undef PK
}
__device__ __forceinline__ void pv_d0(f32x16* o, int vb, bf16x8 pa0, bf16x8 pa1, bf16x8 pa2, bf16x8 pa3) {
    pv_one<0>(o[0], vb, pa0, pa1, pa2, pa3); pv_one<1>(o[1], vb, pa0, pa1, pa2, pa3); pv_one<2>(o[2], vb, pa0, pa1, pa2, pa3); pv_one<3>(o[3], vb, pa0, pa1, pa2, pa3);
}

__device__ __forceinline__ void attn_pass(const u16* __restrict__ Qb, const u16* __restrict__ Kh, const u16* __restrict__ Vh, char* lds, f32x16* o, float& l_out) {
    const int tid = otid(), wid = tid >> 6, lane = tid & 63, r32 = lane & 31, hi = lane >> 5;
    char* V_lds = lds; char* K_lds = lds + 2 * SHM_V;
    float* wsl = (float*)(lds + 2 * SHM_V + 2 * SHM_K) + wid * 64; float* al_l = wsl + 32;
    float m_reg = -1e30f, l_reg = 0;
#pragma unroll
    for (int d = 0; d < 4; ++d) o[d] = f32x16{};
    bf16x8 qr[4];
    const u16* Qw = Qb + (size_t)(wid * QBLK + r32) * LDQ + hi * 8;
#pragma unroll
    for (int d0 = 0; d0 < 4; ++d0) qr[d0] = *reinterpret_cast<const bf16x8*>(Qw + d0 * 16);
    const int sr = tid >> 4, sc = (tid & 15) * 8, vst0 = v_st(sr, sc), vst1 = v_st(32 + sr, sc);
    const int kr = tid >> 3, kcB = (tid & 7) * 16, kst = KSWZ(kr, kcB);
    const int vb0 = (int)(uintptr_t)V_lds + v_rd_base(lane);
    struct { bf16x8 vs0, vs1, ks0; } sr_[2];
#define SLOAD(i, k0) do { sr_[i].vs0 = *reinterpret_cast<const bf16x8*>(&Vh[(size_t)((k0) + sr) * LDQ + sc]); sr_[i].vs1 = *reinterpret_cast<const bf16x8*>(&Vh[(size_t)((k0) + 32 + sr) * LDQ + sc]); \
    sr_[i].ks0 = *reinterpret_cast<const bf16x8*>(&Kh[(size_t)((k0) + kr) * LDQ + (tid & 7) * 8]); } while (0)
#define SWRITE(b, i) do { *(bf16x8*)(V_lds + (b) * SHM_V + vst0) = sr_[i].vs0; *(bf16x8*)(V_lds + (b) * SHM_V + vst1) = sr_[i].vs1; \
    *(bf16x8*)(K_lds + (b) * SHM_K + kst) = sr_[i].ks0; } while (0)
#define SWAIT() asm volatile("s_waitcnt vmcnt(3)" ::: "memory")
#define RESC(a) do { if (__any((a) < 1.f)) { if (hi == 0) al_l[r32] = (a); asm volatile("s_waitcnt lgkmcnt(0)" ::: "memory"); \
    _Pragma("unroll") for (int d = 0; d < 4; ++d) _Pragma("unroll") for (int r = 0; r < 16; ++r) o[d][r] *= al_l[crow(r, hi)]; } } while (0)
    f32x16 pA0, pA1, pB0, pB1; float mnA, mnB, alA, alB; bf16x8 pa0, pa1, pa2, pa3; constexpr int NTL = TSEQ / KVBLK;
    constexpr int SE = 0, SO = 1;
    asm volatile("s_waitcnt vmcnt(0)" ::: "memory");
    SLOAD(SE, 0); asm volatile("s_waitcnt vmcnt(0)" ::: "memory"); SWRITE(0, SE); __syncthreads();
    qkt(pA0, pA1, K_lds, qr, r32, hi); partialSM(pA0, pA1, m_reg, mnA, alA);
    SLOAD(SO, KVBLK); SLOAD(SE, 2 * KVBLK);
    SWAIT(); SWRITE(1, SO); __syncthreads();
    for (int j = 1; j + 1 < NTL; j += 2) {
        SBAR(); qkt(pB0, pB1, K_lds + SHM_K, qr, r32, hi);
        finishSM(pA0, pA1, alA, l_reg, pa0, pa1, pa2, pa3); SBAR();
        SLOAD(SO, (j + 2) * KVBLK); SBAR();
        pv_d0(o, vb0, pa0, pa1, pa2, pa3); partialSM(pB0, pB1, m_reg, mnB, alB);
        __syncthreads(); SWAIT(); SWRITE(0, SE);
        RESC(alB); __syncthreads();
        SBAR(); qkt(pA0, pA1, K_lds, qr, r32, hi);
        finishSM(pB0, pB1, alB, l_reg, pa0, pa1, pa2, pa3); SBAR();
        if (j + 3 < NTL) SLOAD(SE, (j + 3) * KVBLK); SBAR();
        pv_d0(o, vb0 + SHM_V, pa0, pa1, pa2, pa3); partialSM(pA0, pA1, m_reg, mnA, alA);
        __syncthreads(); SWAIT(); SWRITE(1, SO);
        RESC(alA); __syncthreads();
    }
    SBAR(); qkt(pB0, pB1, K_lds + SHM_K, qr, r32, hi);
    finishSM(pA0, pA1, alA, l_reg, pa0, pa1, pa2, pa3); SBAR();
    pv_d0(o, vb0, pa0, pa1, pa2, pa3); partialSM(pB0, pB1, m_reg, mnB, alB);
    __syncthreads(); RESC(alB);
    finishSM(pB0, pB1, alB, l_reg, pa0, pa1, pa2, pa3); SBAR();
    pv_d0(o, vb0 + SHM_V, pa0, pa1, pa2, pa3);
    l_out = l_reg;
#undef SLOAD
#undef SWRITE
#undef SWAIT
#undef RESC
}
}

__device__ __forceinline__ void attn_phase(KP P, int l, unsigned char* shm) {
    const int tid = otid(), wid = tid >> 6, lane = tid & 63, r32 = lane & 31, hi = lane >> 5;
    const u16* PDA = (const u16*)(P->ws + WS_PDA); u16* Y = (u16*)(P->ws + WS_XB);
    float* scr = (float*)(P->ws + WS_SCR) + (size_t)blockIdx.x * 256 * 128;
    float* li_l = (float*)(shm + 2 * att::SHM_V + 2 * att::SHM_K) + wid * 64;
    const float lam_init = 0.8f - 0.6f * expf(-0.3f * (float)l);
    float lam;
    { const float* dl = P->in[19] + l * 256; const float p1 = wave_sum(dl[lane] * dl[64 + lane]), p2 = wave_sum(dl[128 + lane] * dl[192 + lane]); lam = expf(p1) - expf(p2) + lam_init; }
    float sg[4];
#pragma unroll
    for (int d0 = 0; d0 < 4; ++d0) sg[d0] = P->in[20][l * 128 + d0 * 32 + r32] * (1.f - lam_init);
    for (int n = blockIdx.x; n < 48 * 32; n += gridDim.x) {
        const int bh = (n >> 8) * 8 + (n & 7), qb = (n & 255) >> 3, b = bh >> 2, h = bh & 3;
        const size_t tok0 = (size_t)b * TSEQ;
        f32x16 o[4]; float l_reg; float rli[16];
#pragma unroll 1
        for (int c = 0; c < 2; ++c) {
            __syncthreads();
            att::attn_pass(PDA + (tok0 + qb * 256) * DAC + h * 128 + c * 64, PDA + tok0 * DAC + 512 + h * 128 + c * 64, PDA + tok0 * DAC + 1024 + h * 128, (char*)shm, o, l_reg);
            asm volatile("s_waitcnt lgkmcnt(0)" ::: "memory");
            if (hi == 0) li_l[r32] = l_reg; asm volatile("s_waitcnt lgkmcnt(0)" ::: "memory");
#pragma unroll
            for (int r = 0; r < 16; ++r) rli[r] = 1.0f / li_l[crow(r, hi)];
            float* scl = scr + (wid * 32 + 4 * hi) * 128 + r32; asm volatile("" : "+v"(scl));
            if (c == 0) {
#pragma unroll
                for (int r = 0; r < 16; ++r)
#pragma unroll
                    for (int d0 = 0; d0 < 4; ++d0) scl[crow(r, 0) * 128 + d0 * 32] = o[d0][r] * rli[r];
            } else {
                u16* yb = Y + (tok0 + qb * 256 + wid * 32 + 4 * hi) * DM + 512 + h * 128 + r32; asm volatile("" : "+v"(yb));
#pragma unroll
                for (int r = 0; r < 16; ++r) {
                    float v[4], ss = 0.f;
#pragma unroll
                    for (int d0 = 0; d0 < 4; ++d0) { const float o0 = __hip_atomic_load(&scl[crow(r, 0) * 128 + d0 * 32], __ATOMIC_RELAXED, __HIP_MEMORY_SCOPE_AGENT);
                        v[d0] = o0 - lam * (o[d0][r] * rli[r]); ss += v[d0] * v[d0]; }
#pragma unroll
                    for (int m = 16; m >= 1; m >>= 1) ss += __shfl_xor(ss, m);
                    const float rs = 1.0f / sqrtf(ss * (1.f / 128.f) + SUBLN_EPS_);
                    u16* yr = yb + crow(r, 0) * DM;
#pragma unroll
                    for (int d0 = 0; d0 < 4; ++d0) yr[d0 * 32] = f2bf(v[d0] * rs * sg[d0]);
                }
            }
        }
    }
}

__device__ __forceinline__ float allred4(float x) {
    { auto rr = __builtin_amdgcn_permlane16_swap(__float_as_uint(x), __float_as_uint(x), false, false); x = __uint_as_float(rr[0]) + __uint_as_float(rr[1]); }
    { auto rr = __builtin_amdgcn_permlane32_swap(__float_as_uint(x), __float_as_uint(x), false, false); x = __uint_as_float(rr[0]) + __uint_as_float(rr[1]); }
    return x;
}
#define DPPX(J) " row_newbcast:" #J " row_mask:0xf bank_mask:0xf\n"
#define SC_FMA(J) "v_fmac_f32_dpp %[acc0], %[x], %[s" #J "]" DPPX(J)
#define SC_FMB(J) "v_fmac_f32_dpp %[acc1], %[x], %[s" #J "]" DPPX(J)
#define SC_MUL(J) "v_mul_f32_dpp %[s" #J "], %[w], %[s" #J "]" DPPX(J)
#define SC_F1(J) "v_fmac_f32_dpp %[s" #J "], %[bb], %[sa]" DPPX(J)
#define SC_F2(J) "v_fmac_f32_dpp %[s" #J "], %[km], %[v]" DPPX(J)
#define SC_OA(J) "v_fmac_f32_dpp %[o0], %[r], %[s" #J "]" DPPX(J)
#define SC_OB(J) "v_fmac_f32_dpp %[o1], %[r], %[s" #J "]" DPPX(J)
#define ALL16(M) M(0) M(1) M(2) M(3) M(4) M(5) M(6) M(7) M(8) M(9) M(10) M(11) M(12) M(13) M(14) M(15)
#define EVEN8(M) M(0) M(2) M(4) M(6) M(8) M(10) M(12) M(14)
#define ODD8(M) M(1) M(3) M(5) M(7) M(9) M(11) M(13) M(15)
#define SIN_(J) [s##J] "v"(s##J),
#define SIO_(J) [s##J] "+v"(s##J),

__device__ __forceinline__ void scan_phase(KP P, int l, unsigned char* shm) {
    const int tid = otid(), wid = tid >> 6, lane = tid & 63, r32 = lane & 31, hi = lane >> 5;
    float* R_ = (float*)shm; float* V_ = R_ + 4096; float* W_ = V_ + 4096; float* NKK_ = W_ + 4096; float* KM_ = NKK_ + 4096; float* BB_ = KM_ + 4096;
    u16* WDX = (u16*)(shm + 98304); u16* ADX = WDX + 64 * 72; float* O_ = (float*)(shm + 98304); float* MU_ = (float*)(shm + 116736);
    const u16* PRW = (const u16*)(P->ws + WS_PRW); u16* OD = (u16*)(P->ws + WS_PDA); float* RK = (float*)(P->ws + WS_RK);
    const int s_ = tid >> 3, g_ = tid & 7;
    for (int u = blockIdx.x; u < 192; u += gridDim.x) {
        const int b = u >> 4, h = (u >> 1) & 7, d = u & 1;
        const int cbase[5] = {64 * h, 512 + 64 * h, 1024 + 64 * h, 1536 + 64 * d, 1664 + 64 * d};
        __syncthreads();
        for (int i = tid; i < 640; i += 512) { const int vec = i >> 7, which = (i >> 6) & 1, n = i & 63;
            const int cb = vec == 0 ? cbase[0] : vec == 1 ? cbase[1] : vec == 2 ? cbase[2] : vec == 3 ? cbase[3] : cbase[4];
            MU_[i] = P->in[8][(size_t)(l * 2 + which) * RWC + cb + n]; }
        const int mat = wid >> 2, mb = (wid >> 1) & 1, nb = wid & 1;
        bf16x8 bfrag[4];
        { const u16* Bt = (const u16*)(P->ws + (mat ? WS_AUP : WS_WUP)) + ((size_t)(l * 2 + d) * 512 + 64 * h + 32 * nb + r32) * 64 + 8 * hi;
#pragma unroll
          for (int ks = 0; ks < 4; ++ks) bfrag[ks] = *reinterpret_cast<const bf16x8*>(Bt + 16 * ks); }
        const float lbias = P->in[mat ? 12 : 10][(size_t)(l * 2 + d) * 512 + 64 * h + 32 * nb + r32];
        float kkc[8], kac[8], rkc[8];
#pragma unroll
        for (int e = 0; e < 8; ++e) { kkc[e] = P->in[14][l * 512 + 64 * h + 8 * g_ + e]; kac[e] = P->in[15][l * 512 + 64 * h + 8 * g_ + e]; rkc[e] = P->in[16][l * 512 + 64 * h + 8 * g_ + e]; }
        float s0 = 0, s1 = 0, s2 = 0, s3 = 0, s4 = 0, s5 = 0, s6 = 0, s7 = 0, s8 = 0, s9 = 0, s10 = 0, s11 = 0, s12 = 0, s13 = 0, s14 = 0, s15 = 0;
        __syncthreads();
        for (int j = 0; j < TSEQ / 64; ++j) {
            { const int tau = 64 * j + s_, t = d ? (TSEQ - 1 - tau) : tau; const size_t token = (size_t)b * TSEQ + t;
#pragma unroll
              for (int vec = 0; vec < 5; ++vec) {
                  const u16* p = PRW + token * RWC + cbase[vec] + 8 * g_;
                  const u32x4 wc = *(const u32x4*)p; u32x4 wp = {0u, 0u, 0u, 0u}, wn = {0u, 0u, 0u, 0u};
                  if (t > 0) wp = *(const u32x4*)(p - RWC); if (t < TSEQ - 1) wn = *(const u32x4*)(p + RWC);
                  float c[8], pv[8], nx[8], x[8]; unpack8(wc, c); unpack8(wp, pv); unpack8(wn, nx);
#pragma unroll
                  for (int e = 0; e < 8; ++e) { const float mp = MU_[vec * 128 + 8 * g_ + e], mn = MU_[vec * 128 + 64 + 8 * g_ + e]; x[e] = c[e] + mp * (pv[e] - c[e]) + mn * (nx[e] - c[e]); }
                  if (vec < 3) { float* dst = (vec == 0 ? R_ : vec == 1 ? KM_ : V_) + s_ * 64 + 8 * g_;
                      *(f32x4*)dst = (f32x4){x[0], x[1], x[2], x[3]}; *(f32x4*)(dst + 4) = (f32x4){x[4], x[5], x[6], x[7]}; }
                  else { if (vec == 3) {
#pragma unroll
                          for (int e = 0; e < 8; ++e) x[e] = tanhf(x[e]); }
                      *(u32x4*)((vec == 3 ? WDX : ADX) + s_ * 72 + 8 * g_) = pack8(x); }
              } }
            __syncthreads();
            { const u16* Ab = (mat ? ADX : WDX) + (32 * mb + r32) * 72 + 8 * hi; f32x16 acc = f32x16{};
#pragma unroll
              for (int ks = 0; ks < 4; ++ks) acc = __builtin_amdgcn_mfma_f32_32x32x16_bf16(*reinterpret_cast<const bf16x8*>(Ab + 16 * ks), bfrag[ks], acc, 0, 0, 0);
#pragma unroll
              for (int i = 0; i < 16; ++i) { const int srow = 32 * mb + crow(i, hi), n = 32 * nb + r32; const float x = acc[i] + lbias;
                  if (mat == 0) { const float sp = fmaxf(-x, 0.f) + log1pf(__expf(-fabsf(x))); W_[srow * 64 + n] = __expf(-__expf(-sp - 0.5f)); }
                  else BB_[srow * 64 + n] = sigmoidf_(x); } }
            __syncthreads();
            { const int tau = 64 * j + s_, t = d ? (TSEQ - 1 - tau) : tau; const size_t token = (size_t)b * TSEQ + t;
              float k[8], a[8], r[8], kkr[8], ss = 0.f;
              { const f32x4 k0 = *(const f32x4*)(KM_ + s_ * 64 + 8 * g_), k1 = *(const f32x4*)(KM_ + s_ * 64 + 8 * g_ + 4), a0 = *(const f32x4*)(BB_ + s_ * 64 + 8 * g_), a1 = *(const f32x4*)(BB_ + s_ * 64 + 8 * g_ + 4),
                            r0 = *(const f32x4*)(R_ + s_ * 64 + 8 * g_), r1 = *(const f32x4*)(R_ + s_ * 64 + 8 * g_ + 4);
#pragma unroll
                for (int e = 0; e < 4; ++e) { k[e] = k0[e]; k[4 + e] = k1[e]; a[e] = a0[e]; a[4 + e] = a1[e]; r[e] = r0[e]; r[4 + e] = r1[e]; } }
#pragma unroll
              for (int e = 0; e < 8; ++e) { kkr[e] = k[e] * kkc[e]; ss += kkr[e] * kkr[e]; }
              ss += __shfl_xor(ss, 1); ss += __shfl_xor(ss, 2); ss += __shfl_xor(ss, 4);
              const float inv = 1.0f / sqrtf(fmaxf(ss, 1e-24f));
              float nk[8], bb[8], km[8], rkp = 0.f;
#pragma unroll
              for (int e = 0; e < 8; ++e) { const float kk = kkr[e] * inv; nk[e] = -kk; bb[e] = kk * a[e]; km[e] = k[e] * (1.f + (a[e] - 1.f) * kac[e]); rkp += r[e] * km[e] * rkc[e]; }
              rkp += __shfl_xor(rkp, 1); rkp += __shfl_xor(rkp, 2); rkp += __shfl_xor(rkp, 4);
              *(f32x4*)(NKK_ + s_ * 64 + 8 * g_) = (f32x4){nk[0], nk[1], nk[2], nk[3]}; *(f32x4*)(NKK_ + s_ * 64 + 8 * g_ + 4) = (f32x4){nk[4], nk[5], nk[6], nk[7]};
              *(f32x4*)(BB_ + s_ * 64 + 8 * g_) = (f32x4){bb[0], bb[1], bb[2], bb[3]}; *(f32x4*)(BB_ + s_ * 64 + 8 * g_ + 4) = (f32x4){bb[4], bb[5], bb[6], bb[7]};
              *(f32x4*)(KM_ + s_ * 64 + 8 * g_) = (f32x4){km[0], km[1], km[2], km[3]}; *(f32x4*)(KM_ + s_ * 64 + 8 * g_ + 4) = (f32x4){km[4], km[5], km[6], km[7]};
              if (g_ == 0) RK[((size_t)d * NT + token) * 8 + h] = rkp; }
            __syncthreads();
            if (wid < 4) {
                float pn[4], pw[4], pb[4], pk[4], pr[4], pv[4];
#pragma unroll
                for (int i = 0; i < 4; ++i) { pn[i] = NKK_[i * 64 + lane]; pw[i] = W_[i * 64 + lane]; pb[i] = BB_[i * 64 + lane]; pk[i] = KM_[i * 64 + lane]; pr[i] = R_[i * 64 + lane]; pv[i] = V_[i * 64 + 16 * wid + (lane & 15)]; }
                for (int st = 0; st < 64; st += 4) {
#pragma unroll
                    for (int i = 0; i < 4; ++i) {
                        const float cn = pn[i], cw = pw[i], cb_ = pb[i], ck = pk[i], cr = pr[i], cv = pv[i];
                        if (st + 4 < 64) { const int sn = st + 4 + i; pn[i] = NKK_[sn * 64 + lane]; pw[i] = W_[sn * 64 + lane]; pb[i] = BB_[sn * 64 + lane]; pk[i] = KM_[sn * 64 + lane]; pr[i] = R_[sn * 64 + lane]; pv[i] = V_[sn * 64 + 16 * wid + (lane & 15)]; }
                        float sa0 = 0.f, sa1 = 0.f;
                        asm volatile("s_nop 1\n" EVEN8(SC_FMA) ODD8(SC_FMB) "s_nop 1\n"
                                     : [acc0] "+v"(sa0), [acc1] "+v"(sa1) : ALL16(SIN_) [x] "v"(cn));
                        const float sa = allred4(sa0 + sa1);
                        float o0 = 0.f, o1 = 0.f;
                        asm volatile("s_nop 1\n" ALL16(SC_MUL) ALL16(SC_F1) ALL16(SC_F2) EVEN8(SC_OA) ODD8(SC_OB) "s_nop 1\n"
                                     : ALL16(SIO_) [o0] "+v"(o0), [o1] "+v"(o1)
                                     : [sa] "v"(sa), [v] "v"(cv), [w] "v"(cw), [bb] "v"(cb_), [km] "v"(ck), [r] "v"(cr));
                        const float oo = allred4(o0 + o1);
                        if (lane < 16) O_[(st + i) * 64 + 16 * wid + lane] = oo;
                    }
                }
            }
            __syncthreads();
            { const int tau = 64 * j + s_, t = d ? (TSEQ - 1 - tau) : tau; const size_t token = (size_t)b * TSEQ + t;
              float f[8]; const f32x4 a0 = *(const f32x4*)(O_ + s_ * 64 + 8 * g_), a1 = *(const f32x4*)(O_ + s_ * 64 + 8 * g_ + 4);
#pragma unroll
              for (int e = 0; e < 4; ++e) { f[e] = a0[e]; f[4 + e] = a1[e]; }
              *(u32x4*)(OD + ((size_t)d * NT + token) * 512 + 64 * h + 8 * g_) = pack8(f); }
            __syncthreads();
        }
    }
}

__device__ __forceinline__ float red32(float x) {
#pragma unroll
    for (int m = 16; m >= 1; m >>= 1) x += __shfl_xor(x, m);
    return x;
}
__device__ __forceinline__ void post_phase(KP P, int l, unsigned char* shm) {
    const int tid = otid(), wid = tid >> 6, lane = tid & 63, r32 = lane & 31, hi = lane >> 5, h = wid;
    u16* GS = (u16*)shm;
    const u16* PRW = (const u16*)(P->ws + WS_PRW); const u16* OD = (const u16*)(P->ws + WS_PDA); const float* RK = (const float*)(P->ws + WS_RK); u16* Y = (u16*)(P->ws + WS_XB);
    const u16* gup0 = (const u16*)(P->ws + WS_GUP) + ((size_t)l * 512 + 64 * h + r32) * 128 + 8 * hi;
    float gng[2], gnb[2], mvp[2], mvn[2];
#pragma unroll
    for (int nb = 0; nb < 2; ++nb) { const int c = 64 * h + 32 * nb + r32; gng[nb] = P->in[17][l * 512 + c]; gnb[nb] = P->in[18][l * 512 + c];
        mvp[nb] = P->in[8][(size_t)(l * 2 + 0) * RWC + 1024 + c]; mvn[nb] = P->in[8][(size_t)(l * 2 + 1) * RWC + 1024 + c]; }
    const int s_ = tid >> 3, g_ = tid & 7;
    const float* mgp0 = P->in[8] + (size_t)(l * 2 + 0) * RWC + 1792 + 16 * g_;
    for (int it = blockIdx.x; it < NT / 64; it += gridDim.x) {
        const size_t tok0 = (size_t)it * 64;
        __syncthreads();
        { const size_t token = tok0 + s_; const int t = (int)(token & (TSEQ - 1));
          const float* mgp = mgp0; asm volatile("" : "+v"(mgp)); const float* mgn = mgp + RWC;
#pragma unroll
          for (int hf = 0; hf < 2; ++hf) {
              const u16* p = PRW + token * RWC + 1792 + 16 * g_ + 8 * hf;
              const u32x4 wc = *(const u32x4*)p; u32x4 wp = {0u, 0u, 0u, 0u}, wn = {0u, 0u, 0u, 0u};
              if (t > 0) wp = *(const u32x4*)(p - RWC); if (t < TSEQ - 1) wn = *(const u32x4*)(p + RWC);
              float c[8], pv[8], nx[8], x[8]; unpack8(wc, c); unpack8(wp, pv); unpack8(wn, nx);
#pragma unroll
              for (int e = 0; e < 8; ++e) { const float xs = c[e] + mgp[8 * hf + e] * (pv[e] - c[e]) + mgn[8 * hf + e] * (nx[e] - c[e]); x[e] = sigmoidf_(xs); }
              *(u32x4*)(GS + s_ * 136 + 16 * g_ + 8 * hf) = pack8(x);
          } }
        __syncthreads();
        f32x16 acc[2][2];
#pragma unroll
        for (int mb = 0; mb < 2; ++mb)
#pragma unroll
            for (int nb = 0; nb < 2; ++nb) acc[mb][nb] = f32x16{};
        const u16* gup = gup0; asm volatile("" : "+v"(gup));
#pragma unroll
        for (int ks = 0; ks < 8; ++ks) {
            const bf16x8 b0 = *reinterpret_cast<const bf16x8*>(gup + 16 * ks), b1 = *reinterpret_cast<const bf16x8*>(gup + 32 * 128 + 16 * ks);
#pragma unroll
            for (int mb = 0; mb < 2; ++mb) { const bf16x8 a = *reinterpret_cast<const bf16x8*>(GS + (32 * mb + r32) * 136 + 16 * ks + 8 * hi);
                acc[mb][0] = __builtin_amdgcn_mfma_f32_32x32x16_bf16(a, b0, acc[mb][0], 0, 0, 0); acc[mb][1] = __builtin_amdgcn_mfma_f32_32x32x16_bf16(a, b1, acc[mb][1], 0, 0, 0); } }
#pragma unroll
        for (int mb = 0; mb < 2; ++mb)
#pragma unroll
            for (int i = 0; i < 16; ++i) {
                const size_t token = tok0 + 32 * mb + crow(i, hi); const int t = (int)(token & (TSEQ - 1));
                float x[2], vs[2];
#pragma unroll
                for (int nb = 0; nb < 2; ++nb) { const int c = 64 * h + 32 * nb + r32;
                    x[nb] = bf2f(OD[token * 512 + c]) + bf2f(OD[((size_t)NT + token) * 512 + c]);
                    const u16* pv = PRW + token * RWC + 1024 + c; const float vc = bf2f(*pv), vp = t > 0 ? bf2f(*(pv - RWC)) : 0.f, vn = t < TSEQ - 1 ? bf2f(*(pv + RWC)) : 0.f;
                    vs[nb] = vc + mvp[nb] * (vp - vc) + mvn[nb] * (vn - vc); }
                const float mu = red32(x[0] + x[1]) * (1.f / 64.f); const float d0 = x[0] - mu, d1 = x[1] - mu;
                const float var = red32(d0 * d0 + d1 * d1) * (1.f / 64.f), rs = 1.0f / sqrtf(var + GN_EPS_);
                const float rk = RK[token * 8 + h] + RK[((size_t)NT + token) * 8 + h];
                Y[token * DM + 64 * h + r32] = f2bf((d0 * rs * gng[0] + gnb[0] + rk * vs[0]) * acc[mb][0][i]);
                Y[token * DM + 64 * h + 32 + r32] = f2bf((d1 * rs * gng[1] + gnb[1] + rk * vs[1]) * acc[mb][1][i]);
            }
    }
}

#define LP launder_kp(P)
__global__ void __launch_bounds__(512, 2) fwd_megakernel(Params Praw) {
    extern __shared__ __attribute__((aligned(16))) unsigned char shm[];
    cg::grid_group grid = cg::this_grid();
    KP P = (KP)__builtin_amdgcn_kernarg_segment_ptr();
    unsigned char* ws = LP->ws;
    float* X = LP->out; u16* XB = (u16*)(ws + WS_XB); u16* HB = (u16*)(ws + WS_BIG);
    phase0(LP, shm);
    grid.sync();
    for (int l = 0; l < DEPTH_; ++l) {
        { EpiSwiglu E; E.H = HB; run_gemm(shm, XB, (const u16*)(ws + WS_WGU) + (size_t)(l * 2 + 0) * NGU * DM, NGU, DM, E); }
        grid.sync();
        { EpiResid E; E.X = X; E.scale = 0.5f; run_gemm(shm, HB, (const u16*)(ws + WS_WDN) + (size_t)(l * 2 + 0) * DM * DFF, DM, DFF, E); }
        grid.sync();
        ln_phase(X, XB, LP->in[2] + (l * 3 + 0) * DM, LP->in[3] + (l * 3 + 0) * DM);
        grid.sync();
        { EpiProj E; E.PRW = (u16*)(ws + WS_PRW); E.PDA = (u16*)(ws + WS_PDA); run_gemm(shm, XB, (const u16*)(ws + WS_WIN) + (size_t)l * NINP * DM, NINP, DM, E); }
        grid.sync();
        rope_phase((u16*)(ws + WS_PDA), (const float*)(ws + WS_ROPE));
        grid.sync();
#ifndef NO_ATTN
        attn_phase(LP, l, shm);
#endif
        grid.sync();
#ifndef NO_SCAN
        scan_phase(LP, l, shm);
#endif
        grid.sync();
#ifndef NO_POST
        post_phase(LP, l, shm);
#endif
        grid.sync();
        { EpiResid E; E.X = X; E.scale = 1.0f; run_gemm(shm, XB, (const u16*)(ws + WS_WOUT) + (size_t)l * DM * DM, DM, DM, E); }
        grid.sync();
        ln_phase(X, XB, LP->in[2] + (l * 3 + 1) * DM, LP->in[3] + (l * 3 + 1) * DM);
        grid.sync();
        { EpiSwiglu E; E.H = HB; run_gemm(shm, XB, (const u16*)(ws + WS_WGU) + (size_t)(l * 2 + 1) * NGU * DM, NGU, DM, E); }
        grid.sync();
        { EpiResid E; E.X = X; E.scale = 0.5f; run_gemm(shm, HB, (const u16*)(ws + WS_WDN) + (size_t)(l * 2 + 1) * DM * DFF, DM, DFF, E); }
        grid.sync();
        ln_phase(X, XB, LP->in[2] + (l * 3 + 2) * DM, LP->in[3] + (l * 3 + 2) * DM);
        grid.sync();
    }
}

extern "C" void kernel_launch(void* const* d_in, const int* in_sizes, int n_in, void* d_out, int out_size, void* d_ws, size_t ws_size, hipStream_t stream) {
    static int grid_blocks = 0;
    if (!grid_blocks) {
        int dev = 0, cus = 0, per_cu = 0;
        (void)hipGetDevice(&dev);
        (void)hipDeviceGetAttribute(&cus, hipDeviceAttributeMultiprocessorCount, dev);
        if (hipFuncSetAttribute((const void*)fwd_megakernel, hipFuncAttributeMaxDynamicSharedMemorySize, LDS_BYTES) != hipSuccess) fprintf(stderr, "kernel_launch: hipFuncSetAttribute failed\n");
        (void)hipOccupancyMaxActiveBlocksPerMultiprocessor(&per_cu, (const void*)fwd_megakernel, 512, LDS_BYTES);
        if (per_cu < 1) per_cu = 1;
        grid_blocks = cus * per_cu;
        if (grid_blocks > 256) grid_blocks = 256;
        if (n_in != 21 || ws_size < WS_END) fprintf(stderr, "kernel_launch: unexpected n_in %d / ws_size %zu (need %zu)\n", n_in, ws_size, (size_t)WS_END);
    }
    Params p{};
    for (int i = 0; i < 21; ++i) p.in[i] = (const float*)d_in[i];
    p.out = (float*)d_out; p.ws = (unsigned char*)d_ws;
    for (int i = 0; i < 32; ++i) p.inv[i] = powf(10000.0f, -(float)(2 * i) / 64.0f);
    void* args[] = {&p};
    hipError_t e = hipLaunchCooperativeKernel((const void*)fwd_megakernel, dim3(grid_blocks), dim3(512), args, LDS_BYTES, stream);
    if (e != hipSuccess) fprintf(stderr, "cooperative launch failed: %s (grid %d)\n", hipGetErrorString(e), grid_blocks);
}
#ifdef TESTK
__global__ void __launch_bounds__(512, 2) tk_phase0(Params Praw) { KP P = (KP)__builtin_amdgcn_kernarg_segment_ptr(); extern __shared__ __attribute__((aligned(16))) unsigned char shm[]; phase0(P, shm); }
__global__ void __launch_bounds__(512, 2) tk_gemm_swiglu(Params Praw) { KP P = (KP)__builtin_amdgcn_kernarg_segment_ptr(); extern __shared__ __attribute__((aligned(16))) unsigned char shm[]; EpiSwiglu E; E.H = (u16*)P->ws; run_gemm(shm, (u16*)P->ws, (const u16*)P->ws, NGU, DM, E); }
__global__ void __launch_bounds__(512, 2) tk_gemm_resid(Params Praw) { KP P = (KP)__builtin_amdgcn_kernarg_segment_ptr(); extern __shared__ __attribute__((aligned(16))) unsigned char shm[]; EpiResid E; E.X = P->out; E.scale = 0.5f; run_gemm(shm, (u16*)P->ws, (const u16*)P->ws, DM, DFF, E); }
__global__ void __launch_bounds__(512, 2) tk_gemm_proj(Params Praw) { KP P = (KP)__builtin_amdgcn_kernarg_segment_ptr(); extern __shared__ __attribute__((aligned(16))) unsigned char shm[]; EpiProj E; E.PRW = (u16*)P->ws; E.PDA = (u16*)P->ws; run_gemm(shm, (u16*)P->ws, (const u16*)P->ws, NINP, DM, E); }
__global__ void __launch_bounds__(512, 2) tk_ln(Params Praw) { KP P = (KP)__builtin_amdgcn_kernarg_segment_ptr(); ln_phase(P->out, (u16*)P->ws, P->in[2], P->in[3]); }
__global__ void __launch_bounds__(512, 2) tk_rope(Params Praw) { KP P = (KP)__builtin_amdgcn_kernarg_segment_ptr(); rope_phase((u16*)P->ws, (const float*)P->ws); }
__global__ void __launch_bounds__(512, 2) tk_attn(Params Praw) { KP P = (KP)__builtin_amdgcn_kernarg_segment_ptr(); extern __shared__ __attribute__((aligned(16))) unsigned char shm[]; attn_phase(P, 1, shm); }
__global__ void __launch_bounds__(512, 2) tk_scan(Params Praw) { KP P = (KP)__builtin_amdgcn_kernarg_segment_ptr(); extern __shared__ __attribute__((aligned(16))) unsigned char shm[]; scan_phase(P, 1, shm); }
__global__ void __launch_bounds__(512, 2) tk_post(Params Praw) { KP P = (KP)__builtin_amdgcn_kernarg_segment_ptr(); extern __shared__ __attribute__((aligned(16))) unsigned char shm[]; post_phase(P, 1, shm); }
#endif
#ifdef TESTK
__global__ void __launch_bounds__(512, 2) tk_attn_pass_only(Params Praw) { KP P = (KP)__builtin_amdgcn_kernarg_segment_ptr(); extern __shared__ __attribute__((aligned(16))) unsigned char shm[];
  f32x16 o[4]; float l_reg; const u16* PDA = (const u16*)P->ws;
  att::attn_pass(PDA + blockIdx.x * 1000, PDA + 512, PDA + 1024, (char*)shm, o, l_reg);
  float* out = P->out + threadIdx.x * 65;
  for (int d = 0; d < 4; ++d) for (int r = 0; r < 16; ++r) out[d * 16 + r] = o[d][r] * l_reg;
}
#endif
```

```cpp
#include <hip/hip_runtime.h>
#include <hip/hip_cooperative_groups.h>
#include <cstdio>
#include <cstdint>
#include <cmath>
namespace cg = cooperative_groups;
__device__ __forceinline__ int otid();

namespace pg8 {
#define PG8_LAS __attribute__((address_space(3)))
typedef unsigned short bf16_t;
typedef short bf16x8 __attribute__((ext_vector_type(8)));
typedef float f32x4 __attribute__((ext_vector_type(4)));
typedef unsigned u32x4 __attribute__((ext_vector_type(4)));
constexpr int BM = 256, BK = 64, HALF = 128, HTB = HALF * BK * 2  , STAGE_BYTES = 8 * HTB, NXCD = 8, WGM = 8;

__host__ __device__ __forceinline__ int lds_byte(int r, int c) { const int st = (r >> 4) * 2 + (c >> 5), rr = r & 15, cc = c & 31, ob = rr * 64 + cc * 2; return st * 1024 + (ob ^ (((ob >> 9) & 1) << 5)); }
__host__ __device__ __forceinline__ void stage_rc(int b, int& R, int& C) { const int st = b / 1024, sb = b % 1024, swz = sb ^ (((sb >> 9) & 1) << 5); R = (st >> 1) * 16 + swz / 64; C = (st & 1) * 32 + (swz % 64) / 2; }
__host__ __device__ __forceinline__ int perm32(int rho) { const int n = rho >> 4, i = rho & 15; return 8 * (i >> 2) + 4 * n + (i & 3); }

struct Unit { int pm, pn; };
struct Gemm { const bf16_t* A; const bf16_t* Bt; int M, N, K; };

struct StaticOrder {
    int nM, nN, nwg, G, c;
    __host__ __device__ void init(int M, int N, int G_, int c_) { nM = M / BM; nN = N / BM; nwg = nM * nN; G = G_; c = c_; }
    __host__ __device__ bool next(int i, Unit& u) const {
        const long L = (long)i * G + c; if (L >= nwg) return false;
        int wgid = (int)L; { const int q = nwg / NXCD, r = nwg % NXCD, xcd = wgid % NXCD, off = wgid / NXCD; wgid = (xcd < r ? xcd * (q + 1) : r * (q + 1) + (xcd - r) * q) + off; }
        const int nig = WGM * nN, gid = wgid / nig, fm = gid * WGM, gsz = (nM - fm) < WGM ? (nM - fm) : WGM;
        u.pm = fm + ((wgid % nig) % gsz); u.pn = (wgid % nig) / gsz; return true;
    }
    __device__ __forceinline__ void a_ready(const Unit&) const {}
    __device__ __forceinline__ void done(const Unit&) const {}
};
__device__ __forceinline__ unsigned cvt_pk_bf16(float lo, float hi) { unsigned r; asm volatile("v_cvt_pk_bf16_f32 %0, %1, %2" : "=v"(r) : "v"(lo), "v"(hi)); return r; }

template <class Epi, class Sched, bool STAMP = false>
__device__ __forceinline__ void gemm_phase(PG8_LAS unsigned char* lds, const Gemm g, const Sched& S, const Epi& E, unsigned long long* stamps) {
    const int tid = otid(), wid = __builtin_amdgcn_readfirstlane(tid >> 6), lane = tid & 63, wr = wid >> 2, wc = wid & 3, fr = lane & 15, fq = lane >> 4;
    const int K = g.K, nt = K / BK;
    int ts_lo = 0, ts_hi = 0, nts = 0; const unsigned long long rt_entry = STAMP ? (unsigned long long)wall_clock64() : 0ull;
#define PG8_STAMP() do { if (STAMP && wid == 0 && nts < 64) { const unsigned long long _c = (unsigned long long)clock64(); \
        ts_lo = (lane == nts) ? (int)(unsigned)_c : ts_lo; ts_hi = (lane == nts) ? (int)(unsigned)(_c >> 32) : ts_hi; ++nts; } } while (0)
    PG8_STAMP();
    unsigned voffA[2], voffB[2];
#pragma unroll
    for (int i = 0; i < 2; ++i) { int R, C; stage_rc(tid * 16 + i * 8192, R, C); const int Rb = Epi::PERM ? ((R & ~31) + perm32(R & 31)) : R;
        voffA[i] = (unsigned)(R * K + C) * 2u; voffB[i] = (unsigned)(Rb * K + C) * 2u; }
    const size_t kstep = (size_t)(BK * 2);
    const size_t hstep = (size_t)HALF * K * 2;
    const size_t tstep = 2 * hstep;
    const unsigned ldsw = (unsigned)wid * 1024u;
    const int aoff = lds_byte(wr * 64 + fr, fq * 8), boff = lds_byte(wc * 32 + fr, fq * 8);
#define PG8_SA(b, h) (((b) * 2 + (h)) * HTB)
#define PG8_SB(b, h) ((4 + (b) * 2 + (h)) * HTB)
#define PG8_STAGE(bufoff, gbase, voff) do { _Pragma("unroll") for (int _i = 0; _i < 2; ++_i) \
        __builtin_amdgcn_global_load_lds((const unsigned*)((const char*)(gbase) + (voff)[_i]), (PG8_LAS unsigned*)(lds + (bufoff) + ldsw + _i * 8192), 16, 0, 0); } while (0)
#define PG8_LDA(dst, b, h) do { _Pragma("unroll") for (int m = 0; m < 4; ++m) _Pragma("unroll") for (int k = 0; k < 2; ++k) dst[m][k] = *(const PG8_LAS bf16x8*)(lds + PG8_SA(b, h) + aoff + m * 2048 + k * 1024); } while (0)
#define PG8_LDB(dst, b, h) do { _Pragma("unroll") for (int n = 0; n < 2; ++n) _Pragma("unroll") for (int k = 0; k < 2; ++k) dst[n][k] = *(const PG8_LAS bf16x8*)(lds + PG8_SB(b, h) + boff + n * 2048 + k * 1024); } while (0)
#define PG8_MMA(ai, bj, At, Bt) do { __builtin_amdgcn_s_setprio(1); _Pragma("unroll") for (int m = 0; m < 4; ++m) _Pragma("unroll") for (int n = 0; n < 2; ++n) _Pragma("unroll") for (int k = 0; k < 2; ++k) \
        acc[ai][bj][m][n] = __builtin_amdgcn_mfma_f32_16x16x32_bf16(Bt[n][k], At[m][k], acc[ai][bj][m][n], 0, 0, 0); __builtin_amdgcn_s_setprio(0); } while (0)
#define PG8_WAIT_V(n) asm volatile("s_waitcnt vmcnt(" #n ")" ::: "memory")
#define PG8_WAIT_L(n) asm volatile("s_waitcnt lgkmcnt(" #n ")" ::: "memory")
#define PG8_BAR __builtin_amdgcn_s_barrier()
#define PG8_SCHED __builtin_amdgcn_sched_barrier(0)
    Unit cur, nxt; int ui = 0;
    if (!S.next(0, cur)) return;
    f32x4 acc[2][2][4][2];
#pragma unroll
    for (int a = 0; a < 2; ++a)
#pragma unroll
        for (int b = 0; b < 2; ++b)
#pragma unroll
            for (int m = 0; m < 4; ++m)
#pragma unroll
                for (int n = 0; n < 2; ++n) acc[a][b][m][n] = (f32x4){0.f, 0.f, 0.f, 0.f};
    bf16x8 At[4][2], B0[2][2], B1[2][2];
    const char* cA = (const char*)g.A + (size_t)cur.pm * tstep; const char* cB = (const char*)g.Bt + (size_t)cur.pn * tstep;
    S.a_ready(cur);
    PG8_STAGE(PG8_SB(0, 0), cB, voffB); PG8_STAGE(PG8_SA(0, 0), cA, voffA); PG8_STAGE(PG8_SB(0, 1), cB + hstep, voffB); PG8_STAGE(PG8_SA(0, 1), cA + hstep, voffA);
    if (wr == 1) PG8_BAR;
    PG8_WAIT_V(4); PG8_BAR;
    PG8_STAGE(PG8_SB(1, 0), cB + kstep, voffB); PG8_STAGE(PG8_SA(1, 0), cA + kstep, voffA); PG8_STAGE(PG8_SB(1, 1), cB + hstep + kstep, voffB);
    PG8_WAIT_V(6); PG8_BAR;
    PG8_STAMP();
    for (;;) {
        const bool has_next = S.next(ui + 1, nxt);
        const char* nA = has_next ? (const char*)g.A + (size_t)nxt.pm * tstep : cA; const char* nB = has_next ? (const char*)g.Bt + (size_t)nxt.pn * tstep : cB;
        for (int t = 0; t < nt; t += 2) {
            const bool last = (t == nt - 2);
            const char* a1 = cA + (size_t)(t + 1) * kstep;
            const char* a2 = last ? nA : cA + (size_t)(t + 2) * kstep; const char* b2 = last ? nB : cB + (size_t)(t + 2) * kstep;
            const char* a3 = a2 + kstep; const char* b3 = b2 + kstep;
            if (last && has_next) S.a_ready(nxt);
            PG8_LDB(B0, 0, 0); PG8_SCHED; PG8_LDA(At, 0, 0); PG8_STAGE(PG8_SA(1, 1), a1 + hstep, voffA);
            PG8_WAIT_L(8); PG8_BAR; PG8_WAIT_L(0); PG8_MMA(0, 0, At, B0); PG8_BAR; PG8_SCHED;
            PG8_LDB(B1, 0, 1); PG8_STAGE(PG8_SB(0, 0), b2, voffB);
            PG8_BAR; PG8_WAIT_L(0); PG8_MMA(0, 1, At, B1); PG8_BAR;
            PG8_LDA(At, 0, 1); PG8_STAGE(PG8_SA(0, 0), a2, voffA);
            PG8_BAR; PG8_WAIT_L(0); PG8_MMA(1, 0, At, B0); PG8_BAR; PG8_SCHED;
            PG8_STAGE(PG8_SB(0, 1), b2 + hstep, voffB);
            PG8_WAIT_V(6); PG8_BAR; PG8_MMA(1, 1, At, B1); PG8_BAR;
            PG8_LDB(B0, 1, 0); PG8_SCHED; PG8_LDA(At, 1, 0); PG8_STAGE(PG8_SA(0, 1), a2 + hstep, voffA);
            PG8_WAIT_L(8); PG8_BAR; PG8_WAIT_L(0); PG8_MMA(0, 0, At, B0); PG8_BAR; PG8_SCHED;
            PG8_LDB(B1, 1, 1); PG8_STAGE(PG8_SB(1, 0), b3, voffB);
            PG8_BAR; PG8_WAIT_L(0); PG8_MMA(0, 1, At, B1); PG8_BAR;
            PG8_LDA(At, 1, 1); PG8_STAGE(PG8_SA(1, 0), a3, voffA);
            PG8_BAR; PG8_WAIT_L(0); PG8_MMA(1, 0, At, B0); PG8_BAR; PG8_SCHED;
            PG8_STAGE(PG8_SB(1, 1), b3 + hstep, voffB);
            PG8_WAIT_V(6); PG8_BAR; PG8_MMA(1, 1, At, B1); PG8_BAR;
        }
        PG8_STAMP();
        if constexpr (!Epi::AFTER_DRAIN) { E(acc, cur, wr, wc, fr, fq); S.done(cur); }
        PG8_STAMP();
        if (!has_next) break;
#pragma unroll
        for (int a = 0; a < 2; ++a)
#pragma unroll
            for (int b = 0; b < 2; ++b)
#pragma unroll
                for (int m = 0; m < 4; ++m)
#pragma unroll
                    for (int n = 0; n < 2; ++n) acc[a][b][m][n] = (f32x4){0.f, 0.f, 0.f, 0.f};
        cur = nxt; cA = nA; cB = nB; ++ui;
    }
    PG8_WAIT_V(0);
    if (wr == 0) PG8_BAR;
    PG8_BAR;
    if constexpr (Epi::AFTER_DRAIN) { E.fused(acc, cur, wr, wc, fr, fq, lds, wid, lane); S.done(cur); }
    PG8_STAMP();
    if (STAMP && wid == 0) { stamps[lane] = lane < nts ? (((unsigned long long)(unsigned)ts_hi << 32) | (unsigned)ts_lo) : 0ull;
        if (lane == 62) stamps[62] = rt_entry; if (lane == 63) stamps[63] = (unsigned long long)wall_clock64(); }
#undef PG8_STAMP
#undef PG8_SA
#undef PG8_SB
#undef PG8_STAGE
#undef PG8_LDA
#undef PG8_LDB
#undef PG8_MMA
#undef PG8_WAIT_V
#undef PG8_WAIT_L
#undef PG8_BAR
#undef PG8_SCHED
}
}

typedef unsigned short u16;
using pg8::bf16x8; using pg8::f32x4; using pg8::u32x4;
typedef short s16x4 __attribute__((ext_vector_type(4)));
typedef float f32x16 __attribute__((ext_vector_type(16)));
typedef unsigned u32x2 __attribute__((ext_vector_type(2)));

constexpr int DM = 1024, TSEQ = 8192, NSEQ = 12, NT = NSEQ * TSEQ, DEPTH_ = 2;
constexpr int DFF = 2816, NGU = 2 * DFF, NIN = 3456, NINP = 3584, RWC = 1920, DAC = 1536;
constexpr float ALPHA_ = 1.4142135623730951f;
constexpr float LN_EPS_ = 1e-5f, GN_EPS_ = 64e-5f, SUBLN_EPS_ = 1e-5f;
constexpr int LDS_BYTES = 163840;

constexpr size_t WS_WGU = 0;
constexpr size_t WS_WDN = WS_WGU + (size_t)2 * 2 * NGU * DM * 2;
constexpr size_t WS_WIN = WS_WDN + (size_t)2 * 2 * DM * DFF * 2;
constexpr size_t WS_WOUT = WS_WIN + (size_t)2 * NINP * DM * 2;
constexpr size_t WS_WUP = WS_WOUT + (size_t)2 * DM * DM * 2;
constexpr size_t WS_AUP = WS_WUP + (size_t)2 * 2 * 512 * 64 * 2;
constexpr size_t WS_GUP = WS_AUP + (size_t)2 * 2 * 512 * 64 * 2;
constexpr size_t WS_ROPE = WS_GUP + (size_t)2 * 512 * 128 * 2;
constexpr size_t WS_RK = WS_ROPE + (size_t)TSEQ * 32 * 2 * 4;
constexpr size_t WS_SCR = WS_RK + (size_t)2 * NT * 8 * 4;
constexpr size_t WS_Q = WS_SCR + (size_t)256 * 256 * 128 * 4;
constexpr size_t WS_XB = WS_Q + (size_t)4096;
constexpr size_t WS_BIG = WS_XB + (size_t)NT * DM * 2;
constexpr size_t WS_PRW = WS_BIG;
constexpr size_t WS_PDA = WS_PRW + (size_t)NT * RWC * 2;
constexpr size_t WS_END = WS_PDA + (size_t)NT * DAC * 2;
static_assert(WS_BIG + (size_t)NT * DFF * 2 <= WS_END, "H fits");
static_assert(WS_END <= (size_t)1073741824, "workspace budget");

struct Params {
    const float* in[21];
    float* out;
    unsigned char* ws;
    float inv[32];
};

typedef const __attribute__((address_space(4))) Params* KP;
__device__ __forceinline__ KP launder_kp(KP p) { asm volatile("" : "+s"(p)); return p; }
__device__ __forceinline__ int otid() { int t = threadIdx.x; asm volatile("" : "+v"(t)); return t; }
__device__ __forceinline__ float bf2f(u16 b) { return __uint_as_float(((unsigned)b) << 16); }
__device__ __forceinline__ float bflo(unsigned w) { return __uint_as_float(w << 16); }
__device__ __forceinline__ float bfhi(unsigned w) { return __uint_as_float(w & 0xffff0000u); }
__device__ __forceinline__ unsigned cvtpk(float lo, float hi) { return pg8::cvt_pk_bf16(lo, hi); }
__device__ __forceinline__ u16 f2bf(float x) { return (u16)(cvtpk(x, 0.f) & 0xffffu); }
__device__ __forceinline__ void unpack8(const u32x4 w, float* f) {
    f[0] = bflo(w[0]); f[1] = bfhi(w[0]); f[2] = bflo(w[1]); f[3] = bfhi(w[1]); f[4] = bflo(w[2]); f[5] = bfhi(w[2]); f[6] = bflo(w[3]); f[7] = bfhi(w[3]);
}
__device__ __forceinline__ u32x4 pack8(const float* f) { u32x4 w = {cvtpk(f[0], f[1]), cvtpk(f[2], f[3]), cvtpk(f[4], f[5]), cvtpk(f[6], f[7])}; return w; }
__device__ __forceinline__ int crow(int r, int hi) { return (r & 3) + 8 * (r >> 2) + 4 * hi; }
__device__ __forceinline__ float sigmoidf_(float x) { return 1.f / (1.f + __expf(-x)); }

struct EpiSwiglu {
    static constexpr bool PERM = true, AFTER_DRAIN = false;
    u16* H;
    __device__ __forceinline__ void operator()(const f32x4 (&acc)[2][2][4][2], const pg8::Unit& u, int wr, int wc, int fr, int fq) const {
        const int row0 = u.pm * 256 + wr * 64 + fr, col0 = u.pn * 128 + wc * 32 + 8 * fq;
#pragma unroll
        for (int ai = 0; ai < 2; ++ai)
#pragma unroll
            for (int m = 0; m < 4; ++m) {
                float o[8];
#pragma unroll
                for (int n = 0; n < 2; ++n)
#pragma unroll
                    for (int e = 0; e < 4; ++e) { const float g = acc[ai][0][m][n][e], up = acc[ai][1][m][n][e]; o[n * 4 + e] = g * __builtin_amdgcn_rcpf(1.f + __builtin_amdgcn_exp2f(g * -1.4426950408889634f)) * up; }
                __builtin_nontemporal_store(pack8(o), (u32x4*)(H + (size_t)(row0 + ai * 128 + m * 16) * DFF + col0));
            }
    }
};
struct EpiResid {
    static constexpr bool PERM = false, AFTER_DRAIN = false;
    float* X; float scale; const float* S0; const float* S1;
    __device__ __forceinline__ void operator()(const f32x4 (&acc)[2][2][4][2], const pg8::Unit& u, int wr, int wc, int fr, int fq) const {
        const int row0 = u.pm * 256 + wr * 64 + fr, col0 = u.pn * 256 + wc * 32 + 4 * fq;
        const float* src = u.pm < 256 ? S0 : S1 - (size_t)65536 * DM * (S1 != X);
#pragma unroll
        for (int ai = 0; ai < 2; ++ai)
#pragma unroll
            for (int m = 0; m < 4; ++m) { const size_t ro = (size_t)(row0 + ai * 128 + m * 16) * DM + col0;
#pragma unroll
                for (int bj = 0; bj < 2; ++bj)
#pragma unroll
                    for (int n = 0; n < 2; ++n) { const f32x4 x = *(const f32x4*)(src + ro + bj * 128 + n * 16); *(f32x4*)(X + ro + bj * 128 + n * 16) = x * ALPHA_ + acc[ai][bj][m][n] * scale; } }
    }
};
struct EpiProj {
    static constexpr bool PERM = true, AFTER_DRAIN = false;
    u16* PRW; u16* PDA; const float* rt;
    __device__ __forceinline__ void operator()(const f32x4 (&acc)[2][2][4][2], const pg8::Unit& u, int wr, int wc, int fr, int fq) const {
        const int row0 = u.pm * 256 + wr * 64 + fr;
#pragma unroll
        for (int bj = 0; bj < 2; ++bj) {
            const int cb = u.pn * 256 + bj * 128;
            if (cb >= RWC && cb < RWC + 1024) {
                const int i4 = 4 * (4 * (wc & 1) + fq);
                u16* vb = PDA + (cb - RWC) + 64 * (wc >> 1) + i4;
#pragma unroll
                for (int ai = 0; ai < 2; ++ai)
#pragma unroll
                    for (int m = 0; m < 4; ++m) {
                        const int row = row0 + ai * 128 + m * 16, pos = row & (TSEQ - 1);
                        const f32x4 t0 = *(const f32x4*)(rt + (pos * 32 + i4) * 2), t1 = *(const f32x4*)(rt + (pos * 32 + i4) * 2 + 4);
                        const f32x4 x1 = acc[ai][bj][m][0], x2 = acc[ai][bj][m][1];
                        const f32x4 cs = {t0[0], t0[2], t1[0], t1[2]}, sn = {t0[1], t0[3], t1[1], t1[3]};
                        const f32x4 o1 = x1 * cs - x2 * sn, o2 = x2 * cs + x1 * sn;
                        u32x2 w1 = {cvtpk(o1[0], o1[1]), cvtpk(o1[2], o1[3])}, w2 = {cvtpk(o2[0], o2[1]), cvtpk(o2[2], o2[3])};
                        *(u32x2*)(vb + (size_t)row * DAC) = w1; *(u32x2*)(vb + (size_t)row * DAC + 32) = w2;
                    }
                continue;
            }
            u16* base; int ld;
            if (cb < RWC) { base = PRW + cb; ld = RWC; } else if (cb < NIN) { base = PDA + (cb - RWC); ld = DAC; } else continue;
            base += wc * 32 + 8 * fq;
#pragma unroll
            for (int ai = 0; ai < 2; ++ai)
#pragma unroll
                for (int m = 0; m < 4; ++m) {
                    float o[8];
#pragma unroll
                    for (int n = 0; n < 2; ++n)
#pragma unroll
                        for (int e = 0; e < 4; ++e) o[n * 4 + e] = acc[ai][bj][m][n][e];
                    *(u32x4*)(base + (size_t)(row0 + ai * 128 + m * 16) * ld) = pack8(o);
                }
        }
    }
};

template <class Epi>
__device__ __forceinline__ void run_gemm(unsigned char* shm, const u16* A, const u16* Bt, int N, int K, const Epi& E) {
    pg8::Gemm g; g.A = A; g.Bt = Bt; g.M = NT; g.N = N; g.K = K;
    pg8::StaticOrder S; S.init(NT, N, (int)gridDim.x, (int)blockIdx.x);
    pg8::gemm_phase<Epi, pg8::StaticOrder, false>((PG8_LAS unsigned char*)shm, g, S, E, nullptr);
}

template <int MAP>
__device__ __forceinline__ void tr_job(const float* __restrict__ src, int K, int ld, u16* __restrict__ dst, int Ndst, float* tile) {
    const int tid = otid(), ntk = K / 64, ntn = Ndst / 64;
    for (int ti = blockIdx.x; ti < ntk * ntn; ti += gridDim.x) {
        const int tn = ti / ntk, tk = ti % ntk, n0 = tn * 64, k0 = tk * 64;
        int sc0 = n0; bool zero = false;
        if (MAP == 1) { const int pn = n0 >> 8, bj = (n0 >> 7) & 1, c = n0 & 127; sc0 = bj * DFF + pn * 128 + c; }
        if (MAP == 2) zero = n0 >= NIN;
        const int c4 = (tid & 15) * 4;
#pragma unroll
        for (int p = 0; p < 2; ++p) { const int kr = (tid >> 4) + p * 32;
            f32x4 v = {0.f, 0.f, 0.f, 0.f}; if (!zero) v = *(const f32x4*)(src + (size_t)(k0 + kr) * ld + sc0 + c4);
            tile[kr * 65 + c4 + 0] = v[0]; tile[kr * 65 + c4 + 1] = v[1]; tile[kr * 65 + c4 + 2] = v[2]; tile[kr * 65 + c4 + 3] = v[3]; }
        __syncthreads();
        { const int nr = tid >> 3, kc = (tid & 7) * 8; float f[8];
          const int nrs = (MAP == 2 && n0 >= RWC && n0 < RWC + 1024) ? (((nr & 7) < 4) ? 4 * (nr >> 3) + (nr & 7) : 32 + 4 * (nr >> 3) + (nr & 7) - 4) : nr;
#pragma unroll
          for (int e = 0; e < 8; ++e) f[e] = tile[(kc + e) * 65 + nrs];
          *(u32x4*)(dst + (size_t)(n0 + nr) * K + k0 + kc) = pack8(f); }
        __syncthreads();
    }
}

__device__ __forceinline__ void phase0(KP P, unsigned char* shm) {
    float* tile = (float*)shm; unsigned char* ws = P->ws;
    for (int i = 0; i < 4; ++i) {
        tr_job<1>(P->in[4] + (size_t)i * DM * NGU, DM, NGU, (u16*)(ws + WS_WGU) + (size_t)i * NGU * DM, NGU, tile);
        tr_job<0>(P->in[5] + (size_t)i * DFF * DM, DFF, DM, (u16*)(ws + WS_WDN) + (size_t)i * DM * DFF, DM, tile);
        tr_job<0>(P->in[9] + (size_t)i * 64 * 512, 64, 512, (u16*)(ws + WS_WUP) + (size_t)i * 512 * 64, 512, tile);
        tr_job<0>(P->in[11] + (size_t)i * 64 * 512, 64, 512, (u16*)(ws + WS_AUP) + (size_t)i * 512 * 64, 512, tile);
    }
    for (int l = 0; l < 2; ++l) {
        tr_job<2>(P->in[6] + (size_t)l * DM * NIN, DM, NIN, (u16*)(ws + WS_WIN) + (size_t)l * NINP * DM, NINP, tile);
        tr_job<0>(P->in[7] + (size_t)l * DM * DM, DM, DM, (u16*)(ws + WS_WOUT) + (size_t)l * DM * DM, DM, tile);
        tr_job<0>(P->in[13] + (size_t)l * 128 * 512, 128, 512, (u16*)(ws + WS_GUP) + (size_t)l * 512 * 128, 512, tile);
    }
    const size_t gt = (size_t)blockIdx.x * 512 + otid(), gn = (size_t)gridDim.x * 512;
    { unsigned* qz = (unsigned*)(ws + WS_Q); for (size_t i = gt; i < 1024; i += gn) qz[i] = 0u; }
    { const size_t n4 = (size_t)NT * DM / 4, np4 = (size_t)8 * TSEQ * DM / 4;
      const f32x4* xp = (const f32x4*)P->in[0]; const f32x4* xs = (const f32x4*)P->in[1]; u32x2* xb = (u32x2*)(ws + WS_XB);
      for (size_t i = gt; i < n4; i += gn) { const f32x4 v = i < np4 ? xp[i] : xs[i - np4]; u32x2 w = {cvtpk(v[0], v[1]), cvtpk(v[2], v[3])}; xb[i] = w; } }
    { float* rt = (float*)(ws + WS_ROPE);
      for (size_t idx = gt; idx < (size_t)TSEQ * 32; idx += gn) {
          const int t = (int)(idx >> 5), i = (int)(idx & 31);
          const float angf = (float)t * P->inv[i];
          const double x = (double)angf, n = rint(x * 0.63661977236758134308), r = fma(-n, 6.123233995736766e-17, fma(-n, 1.5707963267948966, x));
          const int q = ((int)n) & 3; const double r2 = r * r;
          double sn = r2 * (1.0 / 6227020800.0) - (1.0 / 39916800.0); sn = sn * r2 + (1.0 / 362880.0); sn = sn * r2 - (1.0 / 5040.0); sn = sn * r2 + (1.0 / 120.0); sn = sn * r2 - (1.0 / 6.0); sn = sn * r2 * r + r;
          double cs = r2 * (-1.0 / 87178291200.0) + (1.0 / 479001600.0); cs = cs * r2 - (1.0 / 3628800.0); cs = cs * r2 + (1.0 / 40320.0); cs = cs * r2 - (1.0 / 720.0); cs = cs * r2 + (1.0 / 24.0); cs = cs * r2 - 0.5; cs = cs * r2 + 1.0;
          double s_, c_; if (q == 0) { s_ = sn; c_ = cs; } else if (q == 1) { s_ = cs; c_ = -sn; } else if (q == 2) { s_ = -sn; c_ = -cs; } else { s_ = -cs; c_ = sn; }
          rt[idx * 2 + 0] = (float)c_; rt[idx * 2 + 1] = (float)s_;
      } }
}

__device__ __forceinline__ float wave_sum(float x) {
#pragma unroll
    for (int o = 32; o >= 1; o >>= 1) x += __shfl_xor(x, o);
    return x;
}
__device__ __forceinline__ void ln_phase(float* X, u16* Xb, const float* __restrict__ g, const float* __restrict__ b) {
    const int tid_ = otid(), wid = tid_ >> 6, lane = tid_ & 63;
    f32x4 gv[4], bv[4];
#pragma unroll
    for (int j = 0; j < 4; ++j) { gv[j] = *(const f32x4*)(g + j * 256 + lane * 4); bv[j] = *(const f32x4*)(b + j * 256 + lane * 4); }
    for (int row = blockIdx.x * 8 + wid; row < NT; row += gridDim.x * 8) {
        float* xr = X + (size_t)row * DM; f32x4 v[4]; float s = 0.f;
#pragma unroll
        for (int j = 0; j < 4; ++j) { v[j] = *(const f32x4*)(xr + j * 256 + lane * 4); s += v[j][0] + v[j][1] + v[j][2] + v[j][3]; }
        const float mu = wave_sum(s) * (1.f / DM); float q = 0.f;
#pragma unroll
        for (int j = 0; j < 4; ++j) { v[j] = v[j] - mu; q += v[j][0] * v[j][0] + v[j][1] * v[j][1] + v[j][2] * v[j][2] + v[j][3] * v[j][3]; }
        const float rs = 1.0f / sqrtf(wave_sum(q) * (1.f / DM) + LN_EPS_);
#pragma unroll
        for (int j = 0; j < 4; ++j) { const f32x4 y = v[j] * rs * gv[j] + bv[j]; *(f32x4*)(xr + j * 256 + lane * 4) = y;
            u32x2 w = {cvtpk(y[0], y[1]), cvtpk(y[2], y[3])}; *(u32x2*)(Xb + (size_t)row * DM + j * 256 + lane * 4) = w; }
    }
}

__device__ __forceinline__ void rope_phase(u16* PDA, const float* __restrict__ rt) {
    const size_t total = (size_t)NT * 64;
    for (size_t i = (size_t)blockIdx.x * 512 + otid(); i < total; i += (size_t)gridDim.x * 512) {
        const int token = (int)(i >> 6), sub = (int)(i & 63), vec = sub >> 2, f0 = (sub & 3) * 8, pos = token & (TSEQ - 1);
        u16* p = PDA + (size_t)token * DAC + vec * 64 + f0;
        const u32x4 w1 = *(const u32x4*)p, w2 = *(const u32x4*)(p + 32);
        float x1[8], x2[8], o1[8], o2[8]; unpack8(w1, x1); unpack8(w2, x2);
        const float* cs = rt + ((size_t)pos * 32 + f0) * 2;
#pragma unroll
        for (int e = 0; e < 8; ++e) { const float c = cs[2 * e], s = cs[2 * e + 1]; o1[e] = x1[e] * c - x2[e] * s; o2[e] = x2[e] * c + x1[e] * s; }
        *(u32x4*)p = pack8(o1); *(u32x4*)(p + 32) = pack8(o2);
    }
}

namespace att {
constexpr int NW = 8, QBLK = 32, KVBLK = 64, LDQ = DAC;
constexpr float SCALE = 0.125f, THR = 8.f;
constexpr int SHM_V = KVBLK * 128 * 2, SHM_K = KVBLK * 64 * 2;
#define KSWZ(row, colB) ((row) * 128 + ((colB) ^ ((((row) >> 1) & 7) << 4)))
#define SBAR() __builtin_amdgcn_sched_barrier(0)
__device__ __forceinline__ void partialSM(f32x16& p0, f32x16& p1, float& m_reg, float& mn, float& alpha) {
    constexpr float C = SCALE * 1.4426950408889634f;
    float pmax = p0[0];
#pragma unroll
    for (int r = 1; r < 16; ++r) pmax = fmaxf(pmax, p0[r]);
#pragma unroll
    for (int r = 0; r < 16; ++r) pmax = fmaxf(pmax, p1[r]);
    { auto rr = __builtin_amdgcn_permlane32_swap(__float_as_uint(pmax), __float_as_uint(pmax), false, false);
      pmax = fmaxf(__uint_as_float(rr[0]), __uint_as_float(rr[1])); }
    if (__builtin_expect(__all(pmax - m_reg <= THR / SCALE), 1)) { mn = m_reg; alpha = 1.f; }
    else { mn = fmaxf(m_reg, pmax); alpha = __builtin_amdgcn_exp2f((m_reg - mn) * C); m_reg = mn; }
    const float mnC = -mn * C;
#pragma unroll
    for (int r = 0; r < 16; ++r) p0[r] = fmaf(p0[r], C, mnC);
#pragma unroll
    for (int r = 0; r < 16; ++r) p1[r] = fmaf(p1[r], C, mnC);
#pragma unroll
    for (int r = 0; r < 16; ++r) p0[r] = __builtin_amdgcn_exp2f(p0[r]);
}
__device__ __forceinline__ void psm_max(const f32x16& p0, const f32x16& p1, float& m_reg, float& mn, float& alpha) {
    constexpr float C = SCALE * 1.4426950408889634f;
    float pmax = p0[0];
#pragma unroll
    for (int r = 1; r < 16; ++r) pmax = fmaxf(pmax, p0[r]);
#pragma unroll
    for (int r = 0; r < 16; ++r) pmax = fmaxf(pmax, p1[r]);
    { auto rr = __builtin_amdgcn_permlane32_swap(__float_as_uint(pmax), __float_as_uint(pmax), false, false);
      pmax = fmaxf(__uint_as_float(rr[0]), __uint_as_float(rr[1])); }
    if (__builtin_expect(__all(pmax - m_reg <= THR / SCALE), 1)) { mn = m_reg; alpha = 1.f; }
    else { mn = fmaxf(m_reg, pmax); alpha = __builtin_amdgcn_exp2f((m_reg - mn) * C); m_reg = mn; }
}
__device__ __forceinline__ void psm_scale(f32x16& p0, f32x16& p1, float mn) {
    constexpr float C = SCALE * 1.4426950408889634f; const float mnC = -mn * C;
#pragma unroll
    for (int r = 0; r < 16; ++r) p0[r] = fmaf(p0[r], C, mnC);
#pragma unroll
    for (int r = 0; r < 16; ++r) p1[r] = fmaf(p1[r], C, mnC);
}
__device__ __forceinline__ void psm_exp(f32x16& p0) {
#pragma unroll
    for (int r = 0; r < 16; ++r) p0[r] = __builtin_amdgcn_exp2f(p0[r]);
}
__device__ __forceinline__ void finishSM(f32x16& p0, f32x16& p1, float alpha, float& l_reg, bf16x8& pa0, bf16x8& pa1, bf16x8& pa2, bf16x8& pa3) {
#pragma unroll
    for (int r = 0; r < 16; ++r) p1[r] = __builtin_amdgcn_exp2f(p1[r]);
    float ps = 0;
#pragma unroll
    for (int r = 0; r < 16; ++r) ps += p0[r];
#pragma unroll
    for (int r = 0; r < 16; ++r) ps += p1[r];
    { auto rr = __builtin_amdgcn_permlane32_swap(__float_as_uint(ps), __float_as_uint(ps), false, false);
      ps = __uint_as_float(rr[0]) + __uint_as_float(rr[1]); }
    l_reg = l_reg * alpha + ps;
#define PK4(P, BASE, OUT) do { unsigned a0 = cvtpk(P[BASE + 0], P[BASE + 1]), a1 = cvtpk(P[BASE + 2], P[BASE + 3]);   \
    unsigned b0 = cvtpk(P[BASE + 4], P[BASE + 5]), b1 = cvtpk(P[BASE + 6], P[BASE + 7]);                              \
    auto r0 = __builtin_amdgcn_permlane32_swap(a0, b0, false, false); auto r1 = __builtin_amdgcn_permlane32_swap(a1, b1, false, false); \
    u32x4 w = {r0[0], r1[0], r0[1], r1[1]}; OUT = *reinterpret_cast<bf16x8*>(&w); } while (0)
    PK4(p0, 0, pa0); PK4(p0, 8, pa1); PK4(p1, 0, pa2); PK4(p1, 8, pa3);
#undef PK4
}
__device__ __forceinline__ void qkt(f32x16& p0, f32x16& p1, const char* Ks, const bf16x8* qr, int r32, int hi) {
    p0 = f32x16{}; p1 = f32x16{};
#pragma unroll
    for (int d0 = 0; d0 < 4; ++d0) { const int cb = (d0 * 16 + hi * 8) * 2;
        const bf16x8 b0 = *reinterpret_cast<const bf16x8*>(Ks + KSWZ(r32, cb));
        const bf16x8 b1 = *reinterpret_cast<const bf16x8*>(Ks + KSWZ(32 + r32, cb));
        p0 = __builtin_amdgcn_mfma_f32_32x32x16_bf16(b0, qr[d0], p0, 0, 0, 0);
        p1 = __builtin_amdgcn_mfma_f32_32x32x16_bf16(b1, qr[d0], p1, 0, 0, 0); }
}
__device__ __forceinline__ int v_st(int k, int c) { const int kk = (k & ~0xC) | ((k & 4) << 1) | ((k & 8) >> 1); return ((kk >> 3) * 4 + (c >> 5)) * 512 + ((kk & 7) * 32 + (c & 31)) * 2; }
__device__ __forceinline__ int v_rd_base(int lane) { return ((lane & 3) << 3) | (((lane >> 2) & 3) << 6) | (((lane >> 4) & 1) << 5) | (((lane >> 5) & 1) << 8); }
constexpr int v_rd_off(int d0, int ks, int half) { return d0 * 512 + ks * 4096 + half * 2048; }
template <int OFF> __device__ __forceinline__ s16x4 tr_read(int vb) {
    s16x4 r; asm volatile("ds_read_b64_tr_b16 %0, %1 offset:%2" : "=&v"(r) : "v"(vb), "i"(OFF) : "memory"); return r;
}
template <int D0> __device__ __forceinline__ void pv_one(f32x16& od, int vb, bf16x8 pa0, bf16x8 pa1, bf16x8 pa2, bf16x8 pa3) {
    const s16x4 l0 = tr_read<v_rd_off(D0, 0, 0)>(vb), h0 = tr_read<v_rd_off(D0, 0, 1)>(vb), l1 = tr_read<v_rd_off(D0, 1, 0)>(vb), h1 = tr_read<v_rd_off(D0, 1, 1)>(vb);
    const s16x4 l2 = tr_read<v_rd_off(D0, 2, 0)>(vb), h2 = tr_read<v_rd_off(D0, 2, 1)>(vb), l3 = tr_read<v_rd_off(D0, 3, 0)>(vb), h3 = tr_read<v_rd_off(D0, 3, 1)>(vb);
    asm volatile("s_waitcnt lgkmcnt(0)" ::: "memory"); SBAR();
#define PK(L, H) (bf16x8){L[0], L[1], L[2], L[3], H[0], H[1], H[2], H[3]}
    od = __builtin_amdgcn_mfma_f32_32x32x16_bf16(pa0, PK(l0, h0), od, 0, 0, 0);
    od = __builtin_amdgcn_mfma_f32_32x32x16_bf16(pa1, PK(l1, h1), od, 0, 0, 0);
    od = __builtin_amdgcn_mfma_f32_32x32x16_bf16(pa2, PK(l2, h2), od, 0, 0, 0);
    od = __builtin_amdgcn_mfma_f32_32x32x16_bf16(pa3, PK(l3, h3), od, 0, 0, 0);
#undef PK
}
__device__ __forceinline__ void pv_d0(f32x16* o, int vb, bf16x8 pa0, bf16x8 pa1, bf16x8 pa2, bf16x8 pa3) {
    pv_one<0>(o[0], vb, pa0, pa1, pa2, pa3); pv_one<1>(o[1], vb, pa0, pa1, pa2, pa3); pv_one<2>(o[2], vb, pa0, pa1, pa2, pa3); pv_one<3>(o[3], vb, pa0, pa1, pa2, pa3);
}

__device__ __forceinline__ void pv_psm(f32x16* o, int vb, bf16x8 pa0, bf16x8 pa1, bf16x8 pa2, bf16x8 pa3, f32x16& q0, f32x16& q1, float& m_reg, float& mn, float& alpha) {
    pv_one<0>(o[0], vb, pa0, pa1, pa2, pa3); psm_max(q0, q1, m_reg, mn, alpha);
    pv_one<1>(o[1], vb, pa0, pa1, pa2, pa3); psm_scale(q0, q1, mn);
    pv_one<2>(o[2], vb, pa0, pa1, pa2, pa3); psm_exp(q0);
    pv_one<3>(o[3], vb, pa0, pa1, pa2, pa3);
}
__device__ __forceinline__ void attn_pass(const u16* __restrict__ Qb, const u16* __restrict__ Kh, const u16* __restrict__ Vh, char* lds, f32x16* o, float& l_out) {
    const int tid = otid(), wid = tid >> 6, lane = tid & 63, r32 = lane & 31, hi = lane >> 5, cp = wid >> 2, wq = wid & 3;
    char* V_lds = lds; char* K_lds = lds + 2 * SHM_V;
    float* wsl = (float*)(lds + 2 * SHM_V + 4 * SHM_K) + wid * 64; float* al_l = wsl + 32;
    float m_reg = -1e30f, l_reg = 0;
#pragma unroll
    for (int d = 0; d < 4; ++d) o[d] = f32x16{};
    bf16x8 qr[4];
    const u16* Qw = Qb + (size_t)(wq * QBLK + r32) * LDQ + cp * 64 + hi * 8;
#pragma unroll
    for (int d0 = 0; d0 < 4; ++d0) qr[d0] = *reinterpret_cast<const bf16x8*>(Qw + d0 * 16);
    const int sr = tid >> 4, sc = (tid & 15) * 8, vst0 = v_st(sr, sc), vst1 = v_st(32 + sr, sc);
    const int kr = tid >> 3, kcB = (tid & 7) * 16, kst = KSWZ(kr, kcB);
    const int vb0 = (int)(uintptr_t)V_lds + v_rd_base(lane);
    struct { bf16x8 vs0, vs1, ks0, ks1; } sr_[2];
    const char* Kc = K_lds + cp * SHM_K;
#define SLOAD(i, k0) do { sr_[i].vs0 = *reinterpret_cast<const bf16x8*>(&Vh[(size_t)((k0) + sr) * LDQ + sc]); sr_[i].vs1 = *reinterpret_cast<const bf16x8*>(&Vh[(size_t)((k0) + 32 + sr) * LDQ + sc]); \
    sr_[i].ks0 = *reinterpret_cast<const bf16x8*>(&Kh[(size_t)((k0) + kr) * LDQ + (tid & 7) * 8]); sr_[i].ks1 = *reinterpret_cast<const bf16x8*>(&Kh[(size_t)((k0) + kr) * LDQ + 64 + (tid & 7) * 8]); } while (0)
#define SWRITE(b, i) do { *(bf16x8*)(V_lds + (b) * SHM_V + vst0) = sr_[i].vs0; *(bf16x8*)(V_lds + (b) * SHM_V + vst1) = sr_[i].vs1; \
    *(bf16x8*)(K_lds + (b) * 2 * SHM_K + kst) = sr_[i].ks0; *(bf16x8*)(K_lds + (b) * 2 * SHM_K + SHM_K + kst) = sr_[i].ks1; } while (0)
#define SWAIT() asm volatile("s_waitcnt vmcnt(4)" ::: "memory")
#define RESC(a) do { if (__any((a) < 1.f)) { if (hi == 0) al_l[r32] = (a); asm volatile("s_waitcnt lgkmcnt(0)" ::: "memory"); \
    _Pragma("unroll") for (int d = 0; d < 4; ++d) _Pragma("unroll") for (int r = 0; r < 16; ++r) o[d][r] *= al_l[crow(r, hi)]; } } while (0)
    f32x16 pA0, pA1, pB0, pB1; float mnA, mnB, alA, alB; bf16x8 pa0, pa1, pa2, pa3; constexpr int NTL = TSEQ / KVBLK;
    constexpr int SE = 0, SO = 1;
    asm volatile("s_waitcnt vmcnt(0)" ::: "memory");
    SLOAD(SE, 0); asm volatile("s_waitcnt vmcnt(0)" ::: "memory"); SWRITE(0, SE); __syncthreads();
    qkt(pA0, pA1, Kc, qr, r32, hi); partialSM(pA0, pA1, m_reg, mnA, alA);
    SLOAD(SO, KVBLK); SLOAD(SE, 2 * KVBLK);
    SWAIT(); SWRITE(1, SO); __syncthreads();
    for (int j = 1; j + 1 < NTL; j += 2) {
        SBAR(); qkt(pB0, pB1, Kc + 2 * SHM_K, qr, r32, hi);
        finishSM(pA0, pA1, alA, l_reg, pa0, pa1, pa2, pa3); SBAR();
        SLOAD(SO, (j + 2) * KVBLK); SBAR();
        pv_psm(o, vb0, pa0, pa1, pa2, pa3, pB0, pB1, m_reg, mnB, alB);
        __syncthreads(); SWAIT(); SWRITE(0, SE);
        RESC(alB); __syncthreads();
        SBAR(); qkt(pA0, pA1, Kc, qr, r32, hi);
        finishSM(pB0, pB1, alB, l_reg, pa0, pa1, pa2, pa3); SBAR();
        if (j + 3 < NTL) SLOAD(SE, (j + 3) * KVBLK); SBAR();
        pv_psm(o, vb0 + SHM_V, pa0, pa1, pa2, pa3, pA0, pA1, m_reg, mnA, alA);
        __syncthreads(); SWAIT(); SWRITE(1, SO);
        RESC(alA); __syncthreads();
    }
    SBAR(); qkt(pB0, pB1, Kc + 2 * SHM_K, qr, r32, hi);
    finishSM(pA0, pA1, alA, l_reg, pa0, pa1, pa2, pa3); SBAR();
    pv_psm(o, vb0, pa0, pa1, pa2, pa3, pB0, pB1, m_reg, mnB, alB);
    __syncthreads(); RESC(alB);
    finishSM(pB0, pB1, alB, l_reg, pa0, pa1, pa2, pa3); SBAR();
    pv_d0(o, vb0 + SHM_V, pa0, pa1, pa2, pa3);
    l_out = l_reg;
#undef SLOAD
#undef SWRITE
#undef SWAIT
#undef RESC
}
}

__device__ __forceinline__ void attn_phase(KP P, int l, unsigned char* shm) {
    const int tid = otid(), wid = tid >> 6, lane = tid & 63, r32 = lane & 31, hi = lane >> 5, cp = wid >> 2, wq = wid & 3;
    const u16* PDA = (const u16*)(P->ws + WS_PDA); u16* PDAw = (u16*)(P->ws + WS_PDA);
    float* li_l = (float*)(shm + 2 * att::SHM_V + 4 * att::SHM_K) + wid * 64;
    float* XCH = (float*)shm;
    const float lam_init = 0.8f - 0.6f * expf(-0.3f * (float)l);
    float lam;
    { const float* dl = P->in[19] + l * 256; const float p1 = wave_sum(dl[lane] * dl[64 + lane]), p2 = wave_sum(dl[128 + lane] * dl[192 + lane]); lam = expf(p1) - expf(p2) + lam_init; }
    float sg[4];
#pragma unroll
    for (int d0 = 0; d0 < 4; ++d0) sg[d0] = P->in[20][l * 128 + d0 * 32 + r32] * (1.f - lam_init);
    unsigned* qhead = (unsigned*)(P->ws + WS_Q) + l * 128;
    volatile int* slot = (volatile int*)(shm + 2 * att::SHM_V + 4 * att::SHM_K + 2048 + 64);
    const unsigned xcc = ((unsigned)__builtin_amdgcn_s_getreg((3 << 11) | 20)) & 7u;
    for (;;) {
        __syncthreads();
        if (tid == 0) { int item = -1;
            for (unsigned k = 0; k < 8u; ++k) { const unsigned qx = (xcc + k) & 7u; const unsigned idx = __hip_atomic_fetch_add(qhead + qx * 16, 1u, __ATOMIC_RELAXED, __HIP_MEMORY_SCOPE_AGENT);
                if (idx < 384u) { item = (int)(qx * 384u + idx); break; } }
            *slot = item; }
        __syncthreads();
        const int item = *slot; if (item < 0) break;
        const int qx = item / 384, idx = item - qx * 384;
        const int bh = (idx >> 6) * 8 + qx, qb = idx & 63, b = bh >> 2, h = bh & 3;
        const size_t tok0 = (size_t)b * TSEQ;
        f32x16 o[4]; float l_reg; float rli[16];
        __syncthreads();
        att::attn_pass(PDA + (tok0 + qb * 128) * DAC + h * 128, PDA + tok0 * DAC + 512 + h * 128, PDA + tok0 * DAC + 1024 + h * 128, (char*)shm, o, l_reg);
        asm volatile("s_waitcnt lgkmcnt(0)" ::: "memory");
        if (hi == 0) li_l[r32] = l_reg; asm volatile("s_waitcnt lgkmcnt(0)" ::: "memory");
#pragma unroll
        for (int r = 0; r < 16; ++r) rli[r] = 1.0f / li_l[crow(r, hi)];
        __syncthreads();
        if (cp == 1) {
#pragma unroll
            for (int r = 0; r < 16; ++r)
#pragma unroll
                for (int d0 = 0; d0 < 4; ++d0) XCH[((wq * 16 + r) * 4 + d0) * 64 + lane] = o[d0][r] * rli[r];
        }
        __syncthreads();
        if (cp == 0) {
            u16* yb = PDAw + (tok0 + qb * 128 + wq * 32 + 4 * hi) * DAC + h * 128 + r32; asm volatile("" : "+v"(yb));
#pragma unroll
            for (int r = 0; r < 16; ++r) {
                float v[4], ss = 0.f;
#pragma unroll
                for (int d0 = 0; d0 < 4; ++d0) { const float o1n = XCH[((wq * 16 + r) * 4 + d0) * 64 + lane];
                    v[d0] = o[d0][r] * rli[r] - lam * o1n; ss += v[d0] * v[d0]; }
#pragma unroll
                for (int m = 16; m >= 1; m >>= 1) ss += __shfl_xor(ss, m);
                const float rs = 1.0f / sqrtf(ss * (1.f / 128.f) + SUBLN_EPS_);
                u16* yr = yb + crow(r, 0) * DAC;
#pragma unroll
                for (int d0 = 0; d0 < 4; ++d0) yr[d0 * 32] = f2bf(v[d0] * rs * sg[d0]);
            }
        }
    }
}

__device__ __forceinline__ float allred4(float x) {
    { auto rr = __builtin_amdgcn_permlane16_swap(__float_as_uint(x), __float_as_uint(x), false, false); x = __uint_as_float(rr[0]) + __uint_as_float(rr[1]); }
    { auto rr = __builtin_amdgcn_permlane32_swap(__float_as_uint(x), __float_as_uint(x), false, false); x = __uint_as_float(rr[0]) + __uint_as_float(rr[1]); }
    return x;
}
#define DPPX(J) " row_newbcast:" #J " row_mask:0xf bank_mask:0xf\n"
#define SC_FMA(J) "v_fmac_f32_dpp %[acc0], %[x], %[s" #J "]" DPPX(J)
#define SC_FMB(J) "v_fmac_f32_dpp %[acc1], %[x], %[s" #J "]" DPPX(J)
#define SC_MUL(J) "v_mul_f32_dpp %[s" #J "], %[w], %[s" #J "]" DPPX(J)
#define SC_F1(J) "v_fmac_f32_dpp %[s" #J "], %[bb], %[sa]" DPPX(J)
#define SC_F2(J) "v_fmac_f32_dpp %[s" #J "], %[km], %[v]" DPPX(J)
#define SC_OA(J) "v_fmac_f32_dpp %[o0], %[r], %[s" #J "]" DPPX(J)
#define SC_OB(J) "v_fmac_f32_dpp %[o1], %[r], %[s" #J "]" DPPX(J)
#define ALL16(M) M(0) M(1) M(2) M(3) M(4) M(5) M(6) M(7) M(8) M(9) M(10) M(11) M(12) M(13) M(14) M(15)
#define EVEN8(M) M(0) M(2) M(4) M(6) M(8) M(10) M(12) M(14)
#define ODD8(M) M(1) M(3) M(5) M(7) M(9) M(11) M(13) M(15)
#define SIN_(J) [s##J] "v"(s##J),
#define SIO_(J) [s##J] "+v"(s##J),

__device__ __forceinline__ float fsig(float x) { return __builtin_amdgcn_rcpf(1.f + __expf(-x)); }
__device__ __forceinline__ void scan_load(int jn, int p, int lane, int b, int h, int d, const u16* __restrict__ PRW, u32x4 (&raw)[5][3]) {
    const int sl = lane >> 3, g_ = lane & 7, s = 8 * p + sl, tau = 32 * jn + s, t = d ? (TSEQ - 1 - tau) : tau; const size_t token = (size_t)b * TSEQ + t;
    const int cbase[5] = {64 * h, 512 + 64 * h, 1024 + 64 * h, 1536 + 64 * d, 1664 + 64 * d};
#pragma unroll
    for (int vec = 0; vec < 5; ++vec) {
        const u16* q = PRW + token * RWC + cbase[vec] + 8 * g_;
        raw[vec][0] = *(const u32x4*)q; raw[vec][1] = (u32x4){0u, 0u, 0u, 0u}; raw[vec][2] = (u32x4){0u, 0u, 0u, 0u};
        if (t > 0) raw[vec][1] = *(const u32x4*)(q - RWC); if (t < TSEQ - 1) raw[vec][2] = *(const u32x4*)(q + RWC);
    }
}
__device__ __forceinline__ void scan_produce(const u32x4 (&raw)[5][3], int jn, int p, int lane, int b, int h, int d, const u16* __restrict__ PRW, float* RK, unsigned char* ob, u16* WDXp, u16* ADXp,
                                             const float* MU_, const u16* Bw_, const u16* Ba_, const float (&bw)[4], const float (&ba)[4],
                                             const float* kkp_, const float* kap_, const float* rkp_) {
    float* R_ = (float*)ob; float* V_ = R_ + 2048; float* W_ = V_ + 2048; float* NKK_ = W_ + 2048; float* KM_ = NKK_ + 2048; float* BB_ = KM_ + 2048;
    const int sl = lane >> 3, g_ = lane & 7, s = 8 * p + sl, tau = 32 * jn + s, t = d ? (TSEQ - 1 - tau) : tau; const size_t token = (size_t)b * TSEQ + t;
    const int cbase[5] = {64 * h, 512 + 64 * h, 1024 + 64 * h, 1536 + 64 * d, 1664 + 64 * d};
    bf16x8 bfw[4][2], bfa[4][2];
    { const u16* Bw = Bw_; const u16* Ba = Ba_; asm volatile("" : "+v"(Bw), "+v"(Ba));
#pragma unroll
      for (int nb = 0; nb < 4; ++nb)
#pragma unroll
          for (int ks = 0; ks < 2; ++ks) { bfw[nb][ks] = *reinterpret_cast<const bf16x8*>(Bw + nb * 16 * 64 + 32 * ks); bfa[nb][ks] = *reinterpret_cast<const bf16x8*>(Ba + nb * 16 * 64 + 32 * ks); } }
#pragma unroll
    for (int vec = 0; vec < 5; ++vec) {
        float c[8], pv[8], nx[8], x[8]; unpack8(raw[vec][0], c); unpack8(raw[vec][1], pv); unpack8(raw[vec][2], nx);
#pragma unroll
        for (int e = 0; e < 8; ++e) { const float mp = MU_[vec * 128 + 8 * g_ + e], mn = MU_[vec * 128 + 64 + 8 * g_ + e]; x[e] = c[e] + mp * (pv[e] - c[e]) + mn * (nx[e] - c[e]); }
        if (vec < 3) { float* dst = (vec == 0 ? R_ : vec == 1 ? KM_ : V_) + s * 64 + 8 * g_;
            *(f32x4*)dst = (f32x4){x[0], x[1], x[2], x[3]}; *(f32x4*)(dst + 4) = (f32x4){x[4], x[5], x[6], x[7]}; }
        else { if (vec == 3) {
#pragma unroll
                for (int e = 0; e < 8; ++e) x[e] = 1.f - 2.f * __builtin_amdgcn_rcpf(1.f + __expf(2.f * x[e])); }
            *(u32x4*)((vec == 3 ? WDXp : ADXp) + sl * 72 + 8 * g_) = pack8(x); }
    }
    asm volatile("s_waitcnt lgkmcnt(0)" ::: "memory");
    { const int fr = lane & 15, fq = lane >> 4;
      bf16x8 aw[2], aa[2];
#pragma unroll
      for (int ks = 0; ks < 2; ++ks) { aw[ks] = *reinterpret_cast<const bf16x8*>(WDXp + fr * 72 + 32 * ks + 8 * fq); aa[ks] = *reinterpret_cast<const bf16x8*>(ADXp + fr * 72 + 32 * ks + 8 * fq); }
#pragma unroll
      for (int nb = 0; nb < 4; ++nb) {
          f32x4 cw = {0.f, 0.f, 0.f, 0.f}, ca = {0.f, 0.f, 0.f, 0.f};
#pragma unroll
          for (int ks = 0; ks < 2; ++ks) { cw = __builtin_amdgcn_mfma_f32_16x16x32_bf16(aw[ks], bfw[nb][ks], cw, 0, 0, 0); ca = __builtin_amdgcn_mfma_f32_16x16x32_bf16(aa[ks], bfa[nb][ks], ca, 0, 0, 0); }
          if (fq < 2) {
#pragma unroll
              for (int jj = 0; jj < 4; ++jj) { const int srow = 8 * p + 4 * fq + jj, n = 16 * nb + fr;
                  W_[srow * 64 + n] = __expf(-0.60653065971263342f * fsig(cw[jj] + bw[nb]));
                  BB_[srow * 64 + n] = fsig(ca[jj] + ba[nb]); } }
      } }
    asm volatile("s_waitcnt lgkmcnt(0)" ::: "memory");
    { float k[8], a[8], r[8], kkr[8], ss = 0.f, kkc[8], kac[8], rkc[8];
      { const float* kkp = kkp_; const float* kap = kap_; const float* rkp2 = rkp_; asm volatile("" : "+v"(kkp), "+v"(kap), "+v"(rkp2));
        const f32x4 q0 = *(const f32x4*)kkp, q1 = *(const f32x4*)(kkp + 4), q2 = *(const f32x4*)kap, q3 = *(const f32x4*)(kap + 4), q4 = *(const f32x4*)rkp2, q5 = *(const f32x4*)(rkp2 + 4);
#pragma unroll
        for (int e = 0; e < 4; ++e) { kkc[e] = q0[e]; kkc[4 + e] = q1[e]; kac[e] = q2[e]; kac[4 + e] = q3[e]; rkc[e] = q4[e]; rkc[4 + e] = q5[e]; } }
      { const f32x4 k0 = *(const f32x4*)(KM_ + s * 64 + 8 * g_), k1 = *(const f32x4*)(KM_ + s * 64 + 8 * g_ + 4), a0 = *(const f32x4*)(BB_ + s * 64 + 8 * g_), a1 = *(const f32x4*)(BB_ + s * 64 + 8 * g_ + 4),
                    r0 = *(const f32x4*)(R_ + s * 64 + 8 * g_), r1 = *(const f32x4*)(R_ + s * 64 + 8 * g_ + 4);
#pragma unroll
        for (int e = 0; e < 4; ++e) { k[e] = k0[e]; k[4 + e] = k1[e]; a[e] = a0[e]; a[4 + e] = a1[e]; r[e] = r0[e]; r[4 + e] = r1[e]; } }
#pragma unroll
      for (int e = 0; e < 8; ++e) { kkr[e] = k[e] * kkc[e]; ss += kkr[e] * kkr[e]; }
      ss += __shfl_xor(ss, 1); ss += __shfl_xor(ss, 2); ss += __shfl_xor(ss, 4);
      const float inv = __builtin_amdgcn_rsqf(fmaxf(ss, 1e-24f));
      float nk[8], bb[8], km[8], rkp = 0.f;
#pragma unroll
      for (int e = 0; e < 8; ++e) { const float kk = kkr[e] * inv; nk[e] = -kk; bb[e] = kk * a[e]; km[e] = k[e] * (1.f + (a[e] - 1.f) * kac[e]); rkp += r[e] * km[e] * rkc[e]; }
      rkp += __shfl_xor(rkp, 1); rkp += __shfl_xor(rkp, 2); rkp += __shfl_xor(rkp, 4);
      *(f32x4*)(NKK_ + s * 64 + 8 * g_) = (f32x4){nk[0], nk[1], nk[2], nk[3]}; *(f32x4*)(NKK_ + s * 64 + 8 * g_ + 4) = (f32x4){nk[4], nk[5], nk[6], nk[7]};
      *(f32x4*)(BB_ + s * 64 + 8 * g_) = (f32x4){bb[0], bb[1], bb[2], bb[3]}; *(f32x4*)(BB_ + s * 64 + 8 * g_ + 4) = (f32x4){bb[4], bb[5], bb[6], bb[7]};
      *(f32x4*)(KM_ + s * 64 + 8 * g_) = (f32x4){km[0], km[1], km[2], km[3]}; *(f32x4*)(KM_ + s * 64 + 8 * g_ + 4) = (f32x4){km[4], km[5], km[6], km[7]};
      if (g_ == 0) RK[((size_t)d * NT + token) * 8 + h] = rkp; }
}
__device__ __forceinline__ void scan_writeout(int jo, int p, int lane, int b, int h, int d, const float* O_, u16* OD) {
    const int sl = lane >> 3, g_ = lane & 7, s = 8 * p + sl, tau = 32 * jo + s, t = d ? (TSEQ - 1 - tau) : tau; const size_t token = (size_t)b * TSEQ + t;
    float f[8]; const f32x4 a0 = *(const f32x4*)(O_ + s * 64 + 8 * g_), a1 = *(const f32x4*)(O_ + s * 64 + 8 * g_ + 4);
#pragma unroll
    for (int e = 0; e < 4; ++e) { f[e] = a0[e]; f[4 + e] = a1[e]; }
    *(u32x4*)(OD + token * DM + d * 512 + 64 * h + 8 * g_) = pack8(f);
}

__device__ __forceinline__ void scan_phase(KP P, int l, unsigned char* shm) {
    const int tid = otid(), wid = tid >> 6, lane = tid & 63;
    constexpr int NCH = TSEQ / 32, OB_STRIDE = 49152, OO_BASE = 98304, PT_BASE = 114688, MU_BASE = 133120;
    float* MU_ = (float*)(shm + MU_BASE);
    const u16* PRW = (const u16*)(P->ws + WS_PRW); u16* OD = (u16*)(P->ws + WS_XB); float* RK = (float*)(P->ws + WS_RK);
    const int p = wid & 3; u16* WDXp = (u16*)(shm + PT_BASE + p * 4608); u16* ADXp = WDXp + 16 * 72;
    for (int u = blockIdx.x; u < 192; u += gridDim.x) {
        const int b = u >> 4, h = (u >> 1) & 7, d = u & 1;
        __syncthreads();
        for (int i = tid; i < 640; i += 512) { const int vec = i >> 7, which = (i >> 6) & 1, n = i & 63;
            const int cb = vec == 0 ? 64 * h : vec == 1 ? 512 + 64 * h : vec == 2 ? 1024 + 64 * h : vec == 3 ? 1536 + 64 * d : 1664 + 64 * d;
            MU_[i] = P->in[8][(size_t)(l * 2 + which) * RWC + cb + n]; }
        float bw[4], ba[4]; const u16* Bw; const u16* Ba; const float* kkp; const float* kap; const float* rkp;
        { const int fr = lane & 15, fq = lane >> 4, g_ = lane & 7;
          Bw = (const u16*)(P->ws + WS_WUP) + ((size_t)(l * 2 + d) * 512 + 64 * h + fr) * 64 + 8 * fq;
          Ba = (const u16*)(P->ws + WS_AUP) + ((size_t)(l * 2 + d) * 512 + 64 * h + fr) * 64 + 8 * fq;
#pragma unroll
          for (int nb = 0; nb < 4; ++nb) {
              bw[nb] = P->in[10][(size_t)(l * 2 + d) * 512 + 64 * h + 16 * nb + fr]; ba[nb] = P->in[12][(size_t)(l * 2 + d) * 512 + 64 * h + 16 * nb + fr]; }
          kkp = P->in[14] + l * 512 + 64 * h + 8 * g_; kap = P->in[15] + l * 512 + 64 * h + 8 * g_; rkp = P->in[16] + l * 512 + 64 * h + 8 * g_; }
        float s0 = 0, s1 = 0, s2 = 0, s3 = 0, s4 = 0, s5 = 0, s6 = 0, s7 = 0, s8 = 0, s9 = 0, s10 = 0, s11 = 0, s12 = 0, s13 = 0, s14 = 0, s15 = 0;
        __syncthreads();
        u32x4 raw[5][3];
        if (wid >= 4) { scan_load(0, p, lane, b, h, d, PRW, raw); scan_produce(raw, 0, p, lane, b, h, d, PRW, RK, shm, WDXp, ADXp, MU_, Bw, Ba, bw, ba, kkp, kap, rkp); scan_load(1, p, lane, b, h, d, PRW, raw); }
        __syncthreads();
        for (int j = 0; j < NCH; ++j) {
            unsigned char* ob = shm + (j & 1) * OB_STRIDE; float* O_ = (float*)(shm + OO_BASE + (j & 1) * 8192);
            if (wid < 4) {
                const float* R_ = (const float*)ob; const float* V_ = R_ + 2048; const float* W_ = V_ + 2048; const float* NKK_ = W_ + 2048; const float* KM_ = NKK_ + 2048; const float* BB_ = KM_ + 2048;
                float pn[4], pw[4], pb[4], pk[4], pr[4], pv[4];
#pragma unroll
                for (int i = 0; i < 4; ++i) { pn[i] = NKK_[i * 64 + lane]; pw[i] = W_[i * 64 + lane]; pb[i] = BB_[i * 64 + lane]; pk[i] = KM_[i * 64 + lane]; pr[i] = R_[i * 64 + lane]; pv[i] = V_[i * 64 + 16 * wid + (lane & 15)]; }
                for (int st = 0; st < 32; st += 4) {
#pragma unroll
                    for (int i = 0; i < 4; ++i) {
                        const float cn = pn[i], cw = pw[i], cb_ = pb[i], ck = pk[i], cr = pr[i], cv = pv[i];
                        { const int sn = st + 4 + i;
                          pn[i] = NKK_[sn * 64 + lane]; pw[i] = W_[sn * 64 + lane]; pb[i] = BB_[sn * 64 + lane]; pk[i] = KM_[sn * 64 + lane]; pr[i] = R_[sn * 64 + lane]; pv[i] = V_[sn * 64 + 16 * wid + (lane & 15)]; }
                        float sa0 = 0.f, sa1 = 0.f;
                        asm volatile("s_nop 1\n" EVEN8(SC_FMA) ODD8(SC_FMB) "s_nop 1\n"
                                     : [acc0] "+v"(sa0), [acc1] "+v"(sa1) : ALL16(SIN_) [x] "v"(cn));
                        const float sa = allred4(sa0 + sa1);
                        float o0 = 0.f, o1 = 0.f;
                        asm volatile("s_nop 1\n" ALL16(SC_MUL) ALL16(SC_F1) ALL16(SC_F2) EVEN8(SC_OA) ODD8(SC_OB) "s_nop 1\n"
                                     : ALL16(SIO_) [o0] "+v"(o0), [o1] "+v"(o1)
                                     : [sa] "v"(sa), [v] "v"(cv), [w] "v"(cw), [bb] "v"(cb_), [km] "v"(ck), [r] "v"(cr));
                        const float oo = allred4(o0 + o1);
                        O_[(st + i) * 64 + 16 * wid + (lane & 15)] = oo;
                    }
                }
            } else {
                if (j + 1 < NCH) scan_produce(raw, j + 1, p, lane, b, h, d, PRW, RK, shm + ((j + 1) & 1) * OB_STRIDE, WDXp, ADXp, MU_, Bw, Ba, bw, ba, kkp, kap, rkp);
                if (j + 2 < NCH) scan_load(j + 2, p, lane, b, h, d, PRW, raw);
                if (j >= 1) scan_writeout(j - 1, p, lane, b, h, d, (const float*)(shm + OO_BASE + ((j - 1) & 1) * 8192), OD);
            }
            __syncthreads();
        }
        if (wid >= 4) scan_writeout(NCH - 1, p, lane, b, h, d, (const float*)(shm + OO_BASE + ((NCH - 1) & 1) * 8192), OD);
    }
}

__device__ __forceinline__ float red32(float x) {
#pragma unroll
    for (int m = 16; m >= 1; m >>= 1) x += __shfl_xor(x, m);
    return x;
}
__device__ __forceinline__ void post_phase(KP P, int l, unsigned char* shm) {
    const int tid = otid(), wid = tid >> 6, lane = tid & 63, r32 = lane & 31, hi = lane >> 5, h = wid;
    u16* GS = (u16*)shm;
    float* G = (float*)(shm + 17408) + wid * (64 * 68);
    const u16* PRW = (const u16*)(P->ws + WS_PRW); const u16* PDA = (const u16*)(P->ws + WS_PDA); const float* RK = (const float*)(P->ws + WS_RK); u16* Y = (u16*)(P->ws + WS_XB);
    const u16* gup0 = (const u16*)(P->ws + WS_GUP) + ((size_t)l * 512 + 64 * h + r32) * 128 + 8 * hi;
    const int s_ = tid >> 3, g_ = tid & 7, ls = lane >> 3, lg = lane & 7;
    const float* mgp0 = P->in[8] + (size_t)(l * 2 + 0) * RWC + 1792 + 16 * g_;
    float gng[8], gnb[8], mvp[8], mvn[8];
#pragma unroll
    for (int e = 0; e < 8; ++e) { const int c = 64 * h + 8 * lg + e; gng[e] = P->in[17][l * 512 + c]; gnb[e] = P->in[18][l * 512 + c];
        mvp[e] = P->in[8][(size_t)(l * 2 + 0) * RWC + 1024 + c]; mvn[e] = P->in[8][(size_t)(l * 2 + 1) * RWC + 1024 + c]; }
    for (int it = blockIdx.x; it < NT / 64; it += gridDim.x) {
        const size_t tok0 = (size_t)it * 64;
        __syncthreads();
        { const size_t token = tok0 + s_; const int t = (int)(token & (TSEQ - 1));
          const float* mgp = mgp0; asm volatile("" : "+v"(mgp)); const float* mgn = mgp + RWC;
#pragma unroll
          for (int hf = 0; hf < 2; ++hf) {
              const u16* p = PRW + token * RWC + 1792 + 16 * g_ + 8 * hf;
              const u32x4 wc = *(const u32x4*)p; u32x4 wp = {0u, 0u, 0u, 0u}, wn = {0u, 0u, 0u, 0u};
              if (t > 0) wp = *(const u32x4*)(p - RWC); if (t < TSEQ - 1) wn = *(const u32x4*)(p + RWC);
              float c[8], pv[8], nx[8], x[8]; unpack8(wc, c); unpack8(wp, pv); unpack8(wn, nx);
#pragma unroll
              for (int e = 0; e < 8; ++e) { const float xs = c[e] + mgp[8 * hf + e] * (pv[e] - c[e]) + mgn[8 * hf + e] * (nx[e] - c[e]); x[e] = fsig(xs); }
              *(u32x4*)(GS + s_ * 136 + 16 * g_ + 8 * hf) = pack8(x);
          } }
        __syncthreads();
        { f32x16 acc[2][2];
#pragma unroll
          for (int mb = 0; mb < 2; ++mb)
#pragma unroll
              for (int nb = 0; nb < 2; ++nb) acc[mb][nb] = f32x16{};
          const u16* gup = gup0; asm volatile("" : "+v"(gup));
#pragma unroll
          for (int ks = 0; ks < 8; ++ks) {
              const bf16x8 b0 = *reinterpret_cast<const bf16x8*>(gup + 16 * ks), b1 = *reinterpret_cast<const bf16x8*>(gup + 32 * 128 + 16 * ks);
#pragma unroll
              for (int mb = 0; mb < 2; ++mb) { const bf16x8 a = *reinterpret_cast<const bf16x8*>(GS + (32 * mb + r32) * 136 + 16 * ks + 8 * hi);
                  acc[mb][0] = __builtin_amdgcn_mfma_f32_32x32x16_bf16(a, b0, acc[mb][0], 0, 0, 0); acc[mb][1] = __builtin_amdgcn_mfma_f32_32x32x16_bf16(a, b1, acc[mb][1], 0, 0, 0); } }
#pragma unroll
          for (int mb = 0; mb < 2; ++mb)
#pragma unroll
              for (int nb = 0; nb < 2; ++nb)
#pragma unroll
                  for (int i = 0; i < 16; ++i) G[(32 * mb + crow(i, hi)) * 68 + 32 * nb + r32] = acc[mb][nb][i]; }
        asm volatile("s_waitcnt lgkmcnt(0)" ::: "memory");
#pragma unroll 2
        for (int q = 0; q < 8; ++q) {
            const int srow = 8 * q + ls; const size_t token = tok0 + srow; const int t = (int)(token & (TSEQ - 1));
            const u32x4 wo0 = *(const u32x4*)(Y + token * DM + 64 * h + 8 * lg), wo1 = *(const u32x4*)(Y + token * DM + 512 + 64 * h + 8 * lg);
            const u32x4 yda = *(const u32x4*)(PDA + token * DAC + 64 * h + 8 * lg);
            const u16* pvp = PRW + token * RWC + 1024 + 64 * h + 8 * lg;
            const u32x4 wc = *(const u32x4*)pvp; u32x4 wp = {0u, 0u, 0u, 0u}, wn = {0u, 0u, 0u, 0u};
            if (t > 0) wp = *(const u32x4*)(pvp - RWC); if (t < TSEQ - 1) wn = *(const u32x4*)(pvp + RWC);
            const float rk = RK[token * 8 + h] + RK[((size_t)NT + token) * 8 + h];
            const f32x4 g0 = *(const f32x4*)(G + srow * 68 + 8 * lg), g1 = *(const f32x4*)(G + srow * 68 + 8 * lg + 4);
            float o0[8], o1[8], vc[8], vp[8], vn[8], x[8], y[8]; unpack8(wo0, o0); unpack8(wo1, o1); unpack8(wc, vc); unpack8(wp, vp); unpack8(wn, vn);
            float sm = 0.f;
#pragma unroll
            for (int e = 0; e < 8; ++e) { x[e] = o0[e] + o1[e]; sm += x[e]; }
            sm += __shfl_xor(sm, 1); sm += __shfl_xor(sm, 2); sm += __shfl_xor(sm, 4);
            const float mu = sm * (1.f / 64.f); float sq = 0.f;
#pragma unroll
            for (int e = 0; e < 8; ++e) { x[e] -= mu; sq += x[e] * x[e]; }
            sq += __shfl_xor(sq, 1); sq += __shfl_xor(sq, 2); sq += __shfl_xor(sq, 4);
            const float rs = 1.0f / sqrtf(sq * (1.f / 64.f) + GN_EPS_);
#pragma unroll
            for (int e = 0; e < 8; ++e) { const float vs = vc[e] + mvp[e] * (vp[e] - vc[e]) + mvn[e] * (vn[e] - vc[e]); const float gg = e < 4 ? g0[e] : g1[e - 4];
                y[e] = (x[e] * rs * gng[e] + gnb[e] + rk * vs) * gg; }
            *(u32x4*)(Y + token * DM + 64 * h + 8 * lg) = pack8(y); *(u32x4*)(Y + token * DM + 512 + 64 * h + 8 * lg) = yda;
        }
    }
}

#define LP launder_kp(P)
__global__ void __launch_bounds__(512, 2) fwd_megakernel(Params Praw) {
    extern __shared__ __attribute__((aligned(16))) unsigned char shm[];
    cg::grid_group grid = cg::this_grid();
    KP P = (KP)__builtin_amdgcn_kernarg_segment_ptr();
    unsigned char* ws = LP->ws;
    float* X = LP->out; u16* XB = (u16*)(ws + WS_XB); u16* HB = (u16*)(ws + WS_BIG);
    phase0(LP, shm);
    grid.sync();
    for (int l = 0; l < DEPTH_; ++l) {
        { EpiSwiglu E; E.H = HB; run_gemm(shm, XB, (const u16*)(ws + WS_WGU) + (size_t)(l * 2 + 0) * NGU * DM, NGU, DM, E); }
        grid.sync();
        { EpiResid E; E.X = X; E.scale = 0.5f; E.S0 = l == 0 ? LP->in[0] : X; E.S1 = l == 0 ? LP->in[1] : X; run_gemm(shm, HB, (const u16*)(ws + WS_WDN) + (size_t)(l * 2 + 0) * DM * DFF, DM, DFF, E); }
        grid.sync();
        ln_phase(X, XB, LP->in[2] + (l * 3 + 0) * DM, LP->in[3] + (l * 3 + 0) * DM);
        grid.sync();
        { EpiProj E; E.PRW = (u16*)(ws + WS_PRW); E.PDA = (u16*)(ws + WS_PDA); E.rt = (const float*)(ws + WS_ROPE); run_gemm(shm, XB, (const u16*)(ws + WS_WIN) + (size_t)l * NINP * DM, NINP, DM, E); }
        grid.sync();
        scan_phase(LP, l, shm);
        attn_phase(LP, l, shm);
        grid.sync();
#ifndef NO_POST
        post_phase(LP, l, shm);
#endif
        grid.sync();
        { EpiResid E; E.X = X; E.scale = 1.0f; E.S0 = X; E.S1 = X; run_gemm(shm, XB, (const u16*)(ws + WS_WOUT) + (size_t)l * DM * DM, DM, DM, E); }
        grid.sync();
        ln_phase(X, XB, LP->in[2] + (l * 3 + 1) * DM, LP->in[3] + (l * 3 + 1) * DM);
        grid.sync();
        { EpiSwiglu E; E.H = HB; run_gemm(shm, XB, (const u16*)(ws + WS_WGU) + (size_t)(l * 2 + 1) * NGU * DM, NGU, DM, E); }
        grid.sync();
        { EpiResid E; E.X = X; E.scale = 0.5f; E.S0 = X; E.S1 = X; run_gemm(shm, HB, (const u16*)(ws + WS_WDN) + (size_t)(l * 2 + 1) * DM * DFF, DM, DFF, E); }
        grid.sync();
        ln_phase(X, XB, LP->in[2] + (l * 3 + 2) * DM, LP->in[3] + (l * 3 + 2) * DM);
        grid.sync();
    }
}

extern "C" void kernel_launch(void* const* d_in, const int* in_sizes, int n_in, void* d_out, int out_size, void* d_ws, size_t ws_size, hipStream_t stream) {
    static int grid_blocks = 0;
    if (!grid_blocks) {
        int dev = 0, cus = 0, per_cu = 0;
        (void)hipGetDevice(&dev);
        (void)hipDeviceGetAttribute(&cus, hipDeviceAttributeMultiprocessorCount, dev);
        if (hipFuncSetAttribute((const void*)fwd_megakernel, hipFuncAttributeMaxDynamicSharedMemorySize, LDS_BYTES) != hipSuccess) fprintf(stderr, "kernel_launch: hipFuncSetAttribute failed\n");
        (void)hipOccupancyMaxActiveBlocksPerMultiprocessor(&per_cu, (const void*)fwd_megakernel, 512, LDS_BYTES);
        if (per_cu < 1) per_cu = 1;
        grid_blocks = cus * per_cu;
        if (grid_blocks > 256) grid_blocks = 256;
        if (n_in != 21 || ws_size < WS_END) fprintf(stderr, "kernel_launch: unexpected n_in %d / ws_size %zu (need %zu)\n", n_in, ws_size, (size_t)WS_END);
    }
    Params p{};
    for (int i = 0; i < 21; ++i) p.in[i] = (const float*)d_in[i];
    p.out = (float*)d_out; p.ws = (unsigned char*)d_ws;
    for (int i = 0; i < 32; ++i) p.inv[i] = powf(10000.0f, -(float)(2 * i) / 64.0f);
    void* args[] = {&p};
    hipError_t e = hipLaunchCooperativeKernel((const void*)fwd_megakernel, dim3(grid_blocks), dim3(512), args, LDS_BYTES, stream);
    if (e != hipSuccess) fprintf(stderr, "cooperative launch failed: %s (grid %d)\n", hipGetErrorString(e), grid_blocks);
}
#ifdef TESTK
__global__ void __launch_bounds__(512, 2) tk_phase0(Params Praw) { KP P = (KP)__builtin_amdgcn_kernarg_segment_ptr(); extern __shared__ __attribute__((aligned(16))) unsigned char shm[]; phase0(P, shm); }
__global__ void __launch_bounds__(512, 2) tk_gemm_swiglu(Params Praw) { KP P = (KP)__builtin_amdgcn_kernarg_segment_ptr(); extern __shared__ __attribute__((aligned(16))) unsigned char shm[]; EpiSwiglu E; E.H = (u16*)P->ws; run_gemm(shm, (u16*)P->ws, (const u16*)P->ws, NGU, DM, E); }
__global__ void __launch_bounds__(512, 2) tk_gemm_resid(Params Praw) { KP P = (KP)__builtin_amdgcn_kernarg_segment_ptr(); extern __shared__ __attribute__((aligned(16))) unsigned char shm[]; EpiResid E; E.X = P->out; E.scale = 0.5f; run_gemm(shm, (u16*)P->ws, (const u16*)P->ws, DM, DFF, E); }
__global__ void __launch_bounds__(512, 2) tk_gemm_proj(Params Praw) { KP P = (KP)__builtin_amdgcn_kernarg_segment_ptr(); extern __shared__ __attribute__((aligned(16))) unsigned char shm[]; EpiProj E; E.PRW = (u16*)P->ws; E.PDA = (u16*)P->ws; run_gemm(shm, (u16*)P->ws, (const u16*)P->ws, NINP, DM, E); }
__global__ void __launch_bounds__(512, 2) tk_ln(Params Praw) { KP P = (KP)__builtin_amdgcn_kernarg_segment_ptr(); ln_phase(P->out, (u16*)P->ws, P->in[2], P->in[3]); }
__global__ void __launch_bounds__(512, 2) tk_rope(Params Praw) { KP P = (KP)__builtin_amdgcn_kernarg_segment_ptr(); rope_phase((u16*)P->ws, (const float*)P->ws); }
__global__ void __launch_bounds__(512, 2) tk_attn(Params Praw) { KP P = (KP)__builtin_amdgcn_kernarg_segment_ptr(); extern __shared__ __attribute__((aligned(16))) unsigned char shm[]; attn_phase(P, 1, shm); }
__global__ void __launch_bounds__(512, 2) tk_scan(Params Praw) { KP P = (KP)__builtin_amdgcn_kernarg_segment_ptr(); extern __shared__ __attribute__((aligned(16))) unsigned char shm[]; scan_phase(P, 1, shm); }
__global__ void __launch_bounds__(512, 2) tk_post(Params Praw) { KP P = (KP)__builtin_amdgcn_kernarg_segment_ptr(); extern __shared__ __attribute__((aligned(16))) unsigned char shm[]; post_phase(P, 1, shm); }
#endif
#ifdef TESTK
__global__ void __launch_bounds__(512, 2) tk_attn_pass_only(Params Praw) { KP P = (KP)__builtin_amdgcn_kernarg_segment_ptr(); extern __shared__ __attribute__((aligned(16))) unsigned char shm[];
  f32x16 o[4]; float l_reg; const u16* PDA = (const u16*)P->ws;
  att::attn_pass(PDA + blockIdx.x * 1000, PDA + 512, PDA + 1024, (char*)shm, o, l_reg);
  float* out = P->out + threadIdx.x * 65;
  for (int d = 0; d < 4; ++d) for (int r = 0; r < 16; ++r) out[d * 16 + r] = o[d][r] * l_reg;
}
#endif
```

```cpp
#include <hip/hip_runtime.h>
#include <hip/hip_cooperative_groups.h>
#include <cstdio>
#include <cstdint>
#include <cmath>
namespace cg = cooperative_groups;
__device__ __forceinline__ int otid();

namespace pg8 {
#define PG8_LAS __attribute__((address_space(3)))
typedef unsigned short bf16_t;
typedef short bf16x8 __attribute__((ext_vector_type(8)));
typedef float f32x4 __attribute__((ext_vector_type(4)));
typedef unsigned u32x4 __attribute__((ext_vector_type(4)));
constexpr int BM = 256, BK = 64, HALF = 128, HTB = HALF * BK * 2  , STAGE_BYTES = 8 * HTB, NXCD = 8, WGM = 8;

__host__ __device__ __forceinline__ int lds_byte(int r, int c) { const int st = (r >> 4) * 2 + (c >> 5), rr = r & 15, cc = c & 31, ob = rr * 64 + cc * 2; return st * 1024 + (ob ^ (((ob >> 9) & 1) << 5)); }
__host__ __device__ __forceinline__ void stage_rc(int b, int& R, int& C) { const int st = b / 1024, sb = b % 1024, swz = sb ^ (((sb >> 9) & 1) << 5); R = (st >> 1) * 16 + swz / 64; C = (st & 1) * 32 + (swz % 64) / 2; }
__host__ __device__ __forceinline__ int perm32(int rho) { const int n = rho >> 4, i = rho & 15; return 8 * (i >> 2) + 4 * n + (i & 3); }

struct Unit { int pm, pn; };
struct Gemm { const bf16_t* A; const bf16_t* Bt; int M, N, K; };

struct StaticOrder {
    int nM, nN, nwg, G, c;
    __host__ __device__ void init(int M, int N, int G_, int c_) { nM = M / BM; nN = N / BM; nwg = nM * nN; G = G_; c = c_; }
    __host__ __device__ bool next(int i, Unit& u) const {
        const long L = (long)i * G + c; if (L >= nwg) return false;
        int wgid = (int)L; { const int q = nwg / NXCD, r = nwg % NXCD, xcd = wgid % NXCD, off = wgid / NXCD; wgid = (xcd < r ? xcd * (q + 1) : r * (q + 1) + (xcd - r) * q) + off; }
        const int nig = WGM * nN, gid = wgid / nig, fm = gid * WGM, gsz = (nM - fm) < WGM ? (nM - fm) : WGM;
        u.pm = fm + ((wgid % nig) % gsz); u.pn = (wgid % nig) / gsz; return true;
    }
    __device__ __forceinline__ void a_ready(const Unit&) const {}
    __device__ __forceinline__ void done(const Unit&) const {}
};
__device__ __forceinline__ unsigned cvt_pk_bf16(float lo, float hi) { unsigned r; asm volatile("v_cvt_pk_bf16_f32 %0, %1, %2" : "=v"(r) : "v"(lo), "v"(hi)); return r; }

template <class Epi, class Sched, bool STAMP = false>
__device__ __forceinline__ void gemm_phase(PG8_LAS unsigned char* lds, const Gemm g, const Sched& S, const Epi& E, unsigned long long* stamps) {
    const int tid = otid(), wid = __builtin_amdgcn_readfirstlane(tid >> 6), lane = tid & 63, wr = wid >> 2, wc = wid & 3, fr = lane & 15, fq = lane >> 4;
    const int K = g.K, nt = K / BK;
    int ts_lo = 0, ts_hi = 0, nts = 0; const unsigned long long rt_entry = STAMP ? (unsigned long long)wall_clock64() : 0ull;
#define PG8_STAMP() do { if (STAMP && wid == 0 && nts < 64) { const unsigned long long _c = (unsigned long long)clock64(); \
        ts_lo = (lane == nts) ? (int)(unsigned)_c : ts_lo; ts_hi = (lane == nts) ? (int)(unsigned)(_c >> 32) : ts_hi; ++nts; } } while (0)
    PG8_STAMP();
    unsigned voffA[2], voffB[2];
#pragma unroll
    for (int i = 0; i < 2; ++i) { int R, C; stage_rc(tid * 16 + i * 8192, R, C); const int Rb = Epi::PERM ? ((R & ~31) + perm32(R & 31)) : R;
        voffA[i] = (unsigned)(R * K + C) * 2u; voffB[i] = (unsigned)(Rb * K + C) * 2u; }
    const size_t kstep = (size_t)(BK * 2);
    const size_t hstep = (size_t)HALF * K * 2;
    const size_t tstep = 2 * hstep;
    const unsigned ldsw = (unsigned)wid * 1024u;
    const int aoff = lds_byte(wr * 64 + fr, fq * 8), boff = lds_byte(wc * 32 + fr, fq * 8);
#define PG8_SA(b, h) (((b) * 2 + (h)) * HTB)
#define PG8_SB(b, h) ((4 + (b) * 2 + (h)) * HTB)
#define PG8_STAGE(bufoff, gbase, voff) do { _Pragma("unroll") for (int _i = 0; _i < 2; ++_i) \
        __builtin_amdgcn_global_load_lds((const unsigned*)((const char*)(gbase) + (voff)[_i]), (PG8_LAS unsigned*)(lds + (bufoff) + ldsw + _i * 8192), 16, 0, 0); } while (0)
#define PG8_LDA(dst, b, h) do { _Pragma("unroll") for (int m = 0; m < 4; ++m) _Pragma("unroll") for (int k = 0; k < 2; ++k) dst[m][k] = *(const PG8_LAS bf16x8*)(lds + PG8_SA(b, h) + aoff + m * 2048 + k * 1024); } while (0)
#define PG8_LDB(dst, b, h) do { _Pragma("unroll") for (int n = 0; n < 2; ++n) _Pragma("unroll") for (int k = 0; k < 2; ++k) dst[n][k] = *(const PG8_LAS bf16x8*)(lds + PG8_SB(b, h) + boff + n * 2048 + k * 1024); } while (0)
#define PG8_MMA(ai, bj, At, Bt) do { __builtin_amdgcn_s_setprio(1); _Pragma("unroll") for (int m = 0; m < 4; ++m) _Pragma("unroll") for (int n = 0; n < 2; ++n) _Pragma("unroll") for (int k = 0; k < 2; ++k) \
        acc[ai][bj][m][n] = __builtin_amdgcn_mfma_f32_16x16x32_bf16(Bt[n][k], At[m][k], acc[ai][bj][m][n], 0, 0, 0); __builtin_amdgcn_s_setprio(0); } while (0)
#define PG8_WAIT_V(n) asm volatile("s_waitcnt vmcnt(" #n ")" ::: "memory")
#define PG8_WAIT_L(n) asm volatile("s_waitcnt lgkmcnt(" #n ")" ::: "memory")
#define PG8_BAR __builtin_amdgcn_s_barrier()
#define PG8_SCHED __builtin_amdgcn_sched_barrier(0)
    Unit cur, nxt; int ui = 0;
    if (!S.next(0, cur)) return;
    f32x4 acc[2][2][4][2];
#pragma unroll
    for (int a = 0; a < 2; ++a)
#pragma unroll
        for (int b = 0; b < 2; ++b)
#pragma unroll
            for (int m = 0; m < 4; ++m)
#pragma unroll
                for (int n = 0; n < 2; ++n) acc[a][b][m][n] = (f32x4){0.f, 0.f, 0.f, 0.f};
    bf16x8 At[4][2], B0[2][2], B1[2][2];
    const char* cA = (const char*)g.A + (size_t)cur.pm * tstep; const char* cB = (const char*)g.Bt + (size_t)cur.pn * tstep;
    S.a_ready(cur);
    PG8_STAGE(PG8_SB(0, 0), cB, voffB); PG8_STAGE(PG8_SA(0, 0), cA, voffA); PG8_STAGE(PG8_SB(0, 1), cB + hstep, voffB); PG8_STAGE(PG8_SA(0, 1), cA + hstep, voffA);
    if (wr == 1) PG8_BAR;
    PG8_WAIT_V(4); PG8_BAR;
    PG8_STAGE(PG8_SB(1, 0), cB + kstep, voffB); PG8_STAGE(PG8_SA(1, 0), cA + kstep, voffA); PG8_STAGE(PG8_SB(1, 1), cB + hstep + kstep, voffB);
    PG8_WAIT_V(6); PG8_BAR;
    PG8_STAMP();
    for (;;) {
        const bool has_next = S.next(ui + 1, nxt);
        const char* nA = has_next ? (const char*)g.A + (size_t)nxt.pm * tstep : cA; const char* nB = has_next ? (const char*)g.Bt + (size_t)nxt.pn * tstep : cB;
        for (int t = 0; t < nt; t += 2) {
            const bool last = (t == nt - 2);
            const char* a1 = cA + (size_t)(t + 1) * kstep;
            const char* a2 = last ? nA : cA + (size_t)(t + 2) * kstep; const char* b2 = last ? nB : cB + (size_t)(t + 2) * kstep;
            const char* a3 = a2 + kstep; const char* b3 = b2 + kstep;
            if (last && has_next) S.a_ready(nxt);
            PG8_LDB(B0, 0, 0); PG8_SCHED; PG8_LDA(At, 0, 0); PG8_STAGE(PG8_SA(1, 1), a1 + hstep, voffA);
            PG8_WAIT_L(8); PG8_BAR; PG8_WAIT_L(0); PG8_MMA(0, 0, At, B0); PG8_BAR; PG8_SCHED;
            PG8_LDB(B1, 0, 1); PG8_STAGE(PG8_SB(0, 0), b2, voffB);
            PG8_BAR; PG8_WAIT_L(0); PG8_MMA(0, 1, At, B1); PG8_BAR;
            PG8_LDA(At, 0, 1); PG8_STAGE(PG8_SA(0, 0), a2, voffA);
            PG8_BAR; PG8_WAIT_L(0); PG8_MMA(1, 0, At, B0); PG8_BAR; PG8_SCHED;
            PG8_STAGE(PG8_SB(0, 1), b2 + hstep, voffB);
            PG8_WAIT_V(6); PG8_BAR; PG8_MMA(1, 1, At, B1); PG8_BAR;
            PG8_LDB(B0, 1, 0); PG8_SCHED; PG8_LDA(At, 1, 0); PG8_STAGE(PG8_SA(0, 1), a2 + hstep, voffA);
            PG8_WAIT_L(8); PG8_BAR; PG8_WAIT_L(0); PG8_MMA(0, 0, At, B0); PG8_BAR; PG8_SCHED;
            PG8_LDB(B1, 1, 1); PG8_STAGE(PG8_SB(1, 0), b3, voffB);
            PG8_BAR; PG8_WAIT_L(0); PG8_MMA(0, 1, At, B1); PG8_BAR;
            PG8_LDA(At, 1, 1); PG8_STAGE(PG8_SA(1, 0), a3, voffA);
            PG8_BAR; PG8_WAIT_L(0); PG8_MMA(1, 0, At, B0); PG8_BAR; PG8_SCHED;
            PG8_STAGE(PG8_SB(1, 1), b3 + hstep, voffB);
            PG8_WAIT_V(6); PG8_BAR; PG8_MMA(1, 1, At, B1); PG8_BAR;
        }
        PG8_STAMP();
        if constexpr (!Epi::AFTER_DRAIN) { E(acc, cur, wr, wc, fr, fq); S.done(cur); }
        PG8_STAMP();
        if (!has_next) break;
#pragma unroll
        for (int a = 0; a < 2; ++a)
#pragma unroll
            for (int b = 0; b < 2; ++b)
#pragma unroll
                for (int m = 0; m < 4; ++m)
#pragma unroll
                    for (int n = 0; n < 2; ++n) acc[a][b][m][n] = (f32x4){0.f, 0.f, 0.f, 0.f};
        cur = nxt; cA = nA; cB = nB; ++ui;
    }
    PG8_WAIT_V(0);
    if (wr == 0) PG8_BAR;
    PG8_BAR;
    if constexpr (Epi::AFTER_DRAIN) { E.fused(acc, cur, wr, wc, fr, fq, lds, wid, lane); S.done(cur); }
    PG8_STAMP();
    if (STAMP && wid == 0) { stamps[lane] = lane < nts ? (((unsigned long long)(unsigned)ts_hi << 32) | (unsigned)ts_lo) : 0ull;
        if (lane == 62) stamps[62] = rt_entry; if (lane == 63) stamps[63] = (unsigned long long)wall_clock64(); }
#undef PG8_STAMP
#undef PG8_SA
#undef PG8_SB
#undef PG8_STAGE
#undef PG8_LDA
#undef PG8_LDB
#undef PG8_MMA
#undef PG8_WAIT_V
#undef PG8_WAIT_L
#undef PG8_BAR
#undef PG8_SCHED
}
}

typedef unsigned short u16;
using pg8::bf16x8; using pg8::f32x4; using pg8::u32x4;
typedef short s16x4 __attribute__((ext_vector_type(4)));
typedef float f32x16 __attribute__((ext_vector_type(16)));
typedef unsigned u32x2 __attribute__((ext_vector_type(2)));

constexpr int DM = 1024, TSEQ = 8192, NSEQ = 12, NT = NSEQ * TSEQ, DEPTH_ = 2;
constexpr int DFF = 2816, NGU = 2 * DFF, NIN = 3456, NINP = 3584, RWC = 1920, DAC = 1536;
constexpr float ALPHA_ = 1.4142135623730951f;
constexpr float LN_EPS_ = 1e-5f, GN_EPS_ = 64e-5f, SUBLN_EPS_ = 1e-5f;
constexpr int LDS_BYTES = 163840;

constexpr size_t WS_WGU = 0;
constexpr size_t WS_WDN = WS_WGU + (size_t)2 * 2 * NGU * DM * 2;
constexpr size_t WS_WIN = WS_WDN + (size_t)2 * 2 * DM * DFF * 2;
constexpr size_t WS_WOUT = WS_WIN + (size_t)2 * NINP * DM * 2;
constexpr size_t WS_WUP = WS_WOUT + (size_t)2 * DM * DM * 2;
constexpr size_t WS_AUP = WS_WUP + (size_t)2 * 2 * 512 * 64 * 2;
constexpr size_t WS_GUP = WS_AUP + (size_t)2 * 2 * 512 * 64 * 2;
constexpr size_t WS_ROPE = WS_GUP + (size_t)2 * 512 * 128 * 2;
constexpr size_t WS_RK = WS_ROPE + (size_t)TSEQ * 32 * 2 * 4;
constexpr size_t WS_SCR = WS_RK + (size_t)2 * NT * 8 * 4;
constexpr size_t WS_Q = WS_SCR + (size_t)256 * 256 * 128 * 4;
constexpr size_t WS_XB = WS_Q + (size_t)4096;
constexpr size_t WS_BIG = WS_XB + (size_t)NT * DM * 2;
constexpr size_t WS_PRW = WS_BIG;
constexpr size_t WS_PDA = WS_PRW + (size_t)NT * RWC * 2;
constexpr size_t WS_END = WS_PDA + (size_t)NT * DAC * 2;
static_assert(WS_BIG + (size_t)NT * DFF * 2 <= WS_END, "H fits");
static_assert(WS_END <= (size_t)1073741824, "workspace budget");

struct Params {
    const float* in[21];
    float* out;
    unsigned char* ws;
    float inv[32];
};

typedef const __attribute__((address_space(4))) Params* KP;
__device__ __forceinline__ KP launder_kp(KP p) { asm volatile("" : "+s"(p)); return p; }
__device__ __forceinline__ int otid() { int t = threadIdx.x; asm volatile("" : "+v"(t)); return t; }
__device__ __forceinline__ float bf2f(u16 b) { return __uint_as_float(((unsigned)b) << 16); }
__device__ __forceinline__ float bflo(unsigned w) { return __uint_as_float(w << 16); }
__device__ __forceinline__ float bfhi(unsigned w) { return __uint_as_float(w & 0xffff0000u); }
__device__ __forceinline__ unsigned cvtpk(float lo, float hi) { return pg8::cvt_pk_bf16(lo, hi); }
__device__ __forceinline__ u16 f2bf(float x) { return (u16)(cvtpk(x, 0.f) & 0xffffu); }
__device__ __forceinline__ void unpack8(const u32x4 w, float* f) {
    f[0] = bflo(w[0]); f[1] = bfhi(w[0]); f[2] = bflo(w[1]); f[3] = bfhi(w[1]); f[4] = bflo(w[2]); f[5] = bfhi(w[2]); f[6] = bflo(w[3]); f[7] = bfhi(w[3]);
}
__device__ __forceinline__ u32x4 pack8(const float* f) { u32x4 w = {cvtpk(f[0], f[1]), cvtpk(f[2], f[3]), cvtpk(f[4], f[5]), cvtpk(f[6], f[7])}; return w; }
__device__ __forceinline__ int crow(int r, int hi) { return (r & 3) + 8 * (r >> 2) + 4 * hi; }
__device__ __forceinline__ float sigmoidf_(float x) { return 1.f / (1.f + __expf(-x)); }

struct EpiSwiglu {
    static constexpr bool PERM = true, AFTER_DRAIN = false;
    u16* H;
    __device__ __forceinline__ void operator()(const f32x4 (&acc)[2][2][4][2], const pg8::Unit& u, int wr, int wc, int fr, int fq) const {
        const int row0 = u.pm * 256 + wr * 64 + fr, col0 = u.pn * 128 + wc * 32 + 8 * fq;
#pragma unroll
        for (int ai = 0; ai < 2; ++ai)
#pragma unroll
            for (int m = 0; m < 4; ++m) {
                float o[8];
#pragma unroll
                for (int n = 0; n < 2; ++n)
#pragma unroll
                    for (int e = 0; e < 4; ++e) { const float g = acc[ai][0][m][n][e], up = acc[ai][1][m][n][e]; o[n * 4 + e] = g * __builtin_amdgcn_rcpf(1.f + __builtin_amdgcn_exp2f(g * -1.4426950408889634f)) * up; }
                *(u32x4*)(H + (size_t)(row0 + ai * 128 + m * 16) * DFF + col0) = pack8(o);
            }
    }
};
struct EpiResid {
    static constexpr bool PERM = false, AFTER_DRAIN = false;
    float* X; float scale; const float* S0; const float* S1; const u16* SB;
    __device__ __forceinline__ void operator()(const f32x4 (&acc)[2][2][4][2], const pg8::Unit& u, int wr, int wc, int fr, int fq) const {
        const int row0 = u.pm * 256 + wr * 64 + fr, col0 = u.pn * 256 + wc * 32 + 4 * fq;
        const float* src = u.pm < 256 ? S0 : S1 - (size_t)65536 * DM * (S1 != X);
#pragma unroll
        for (int ai = 0; ai < 2; ++ai)
#pragma unroll
            for (int m = 0; m < 4; ++m) { const size_t ro = (size_t)(row0 + ai * 128 + m * 16) * DM + col0;
#pragma unroll
                for (int bj = 0; bj < 2; ++bj)
#pragma unroll
                    for (int n = 0; n < 2; ++n) { f32x4 x;
                        if (SB) { const u32x2 w = *(const u32x2*)(SB + ro + bj * 128 + n * 16); x = (f32x4){bflo(w[0]), bfhi(w[0]), bflo(w[1]), bfhi(w[1])}; }
                        else x = *(const f32x4*)(src + ro + bj * 128 + n * 16);
                        *(f32x4*)(X + ro + bj * 128 + n * 16) = x * ALPHA_ + acc[ai][bj][m][n] * scale; } }
    }
};
struct EpiProj {
    static constexpr bool PERM = true, AFTER_DRAIN = false;
    u16* PRW; u16* PDA; const float* rt;
    __device__ __forceinline__ void operator()(const f32x4 (&acc)[2][2][4][2], const pg8::Unit& u, int wr, int wc, int fr, int fq) const {
        const int row0 = u.pm * 256 + wr * 64 + fr;
#pragma unroll
        for (int bj = 0; bj < 2; ++bj) {
            const int cb = u.pn * 256 + bj * 128;
            if (cb >= RWC && cb < RWC + 1024) {
                const int i4 = 4 * (4 * (wc & 1) + fq);
                u16* vb = PDA + (cb - RWC) + 64 * (wc >> 1) + i4;
#pragma unroll
                for (int ai = 0; ai < 2; ++ai)
#pragma unroll
                    for (int m = 0; m < 4; ++m) {
                        const int row = row0 + ai * 128 + m * 16, pos = row & (TSEQ - 1);
                        const f32x4 t0 = *(const f32x4*)(rt + (pos * 32 + i4) * 2), t1 = *(const f32x4*)(rt + (pos * 32 + i4) * 2 + 4);
                        const f32x4 x1 = acc[ai][bj][m][0], x2 = acc[ai][bj][m][1];
                        const f32x4 cs = {t0[0], t0[2], t1[0], t1[2]}, sn = {t0[1], t0[3], t1[1], t1[3]};
                        const f32x4 o1 = x1 * cs - x2 * sn, o2 = x2 * cs + x1 * sn;
                        u32x2 w1 = {cvtpk(o1[0], o1[1]), cvtpk(o1[2], o1[3])}, w2 = {cvtpk(o2[0], o2[1]), cvtpk(o2[2], o2[3])};
                        *(u32x2*)(vb + (size_t)row * DAC) = w1; *(u32x2*)(vb + (size_t)row * DAC + 32) = w2;
                    }
                continue;
            }
            u16* base; int ld;
            if (cb < RWC) { base = PRW + cb; ld = RWC; } else if (cb < NIN) { base = PDA + (cb - RWC); ld = DAC; } else continue;
            base += wc * 32 + 8 * fq;
#pragma unroll
            for (int ai = 0; ai < 2; ++ai)
#pragma unroll
                for (int m = 0; m < 4; ++m) {
                    float o[8];
#pragma unroll
                    for (int n = 0; n < 2; ++n)
#pragma unroll
                        for (int e = 0; e < 4; ++e) o[n * 4 + e] = acc[ai][bj][m][n][e];
                    *(u32x4*)(base + (size_t)(row0 + ai * 128 + m * 16) * ld) = pack8(o);
                }
        }
    }
};

template <class Epi>
__device__ __forceinline__ void run_gemm(unsigned char* shm, const u16* A, const u16* Bt, int N, int K, const Epi& E) {
    pg8::Gemm g; g.A = A; g.Bt = Bt; g.M = NT; g.N = N; g.K = K;
    pg8::StaticOrder S; S.init(NT, N, (int)gridDim.x, (int)blockIdx.x);
    pg8::gemm_phase<Epi, pg8::StaticOrder, false>((PG8_LAS unsigned char*)shm, g, S, E, nullptr);
}

template <int MAP>
__device__ __forceinline__ void tr_job(const float* __restrict__ src, int K, int ld, u16* __restrict__ dst, int Ndst, float* tile) {
    const int tid = otid(), ntk = K / 64, ntn = Ndst / 64;
    for (int ti = blockIdx.x; ti < ntk * ntn; ti += gridDim.x) {
        const int tn = ti / ntk, tk = ti % ntk, n0 = tn * 64, k0 = tk * 64;
        int sc0 = n0; bool zero = false;
        if (MAP == 1) { const int pn = n0 >> 8, bj = (n0 >> 7) & 1, c = n0 & 127; sc0 = bj * DFF + pn * 128 + c; }
        if (MAP == 2) zero = n0 >= NIN;
        const int c4 = (tid & 15) * 4;
#pragma unroll
        for (int p = 0; p < 2; ++p) { const int kr = (tid >> 4) + p * 32;
            f32x4 v = {0.f, 0.f, 0.f, 0.f}; if (!zero) v = *(const f32x4*)(src + (size_t)(k0 + kr) * ld + sc0 + c4);
            tile[kr * 65 + c4 + 0] = v[0]; tile[kr * 65 + c4 + 1] = v[1]; tile[kr * 65 + c4 + 2] = v[2]; tile[kr * 65 + c4 + 3] = v[3]; }
        __syncthreads();
        { const int nr = tid >> 3, kc = (tid & 7) * 8; float f[8];
          const int nrs = (MAP == 2 && n0 >= RWC && n0 < RWC + 1024) ? (((nr & 7) < 4) ? 4 * (nr >> 3) + (nr & 7) : 32 + 4 * (nr >> 3) + (nr & 7) - 4) : nr;
#pragma unroll
          for (int e = 0; e < 8; ++e) f[e] = tile[(kc + e) * 65 + nrs];
          *(u32x4*)(dst + (size_t)(n0 + nr) * K + k0 + kc) = pack8(f); }
        __syncthreads();
    }
}

__device__ __forceinline__ void phase0(KP P, unsigned char* shm) {
    float* tile = (float*)shm; unsigned char* ws = P->ws;
    for (int i = 0; i < 4; ++i) {
        tr_job<1>(P->in[4] + (size_t)i * DM * NGU, DM, NGU, (u16*)(ws + WS_WGU) + (size_t)i * NGU * DM, NGU, tile);
        tr_job<0>(P->in[5] + (size_t)i * DFF * DM, DFF, DM, (u16*)(ws + WS_WDN) + (size_t)i * DM * DFF, DM, tile);
        tr_job<0>(P->in[9] + (size_t)i * 64 * 512, 64, 512, (u16*)(ws + WS_WUP) + (size_t)i * 512 * 64, 512, tile);
        tr_job<0>(P->in[11] + (size_t)i * 64 * 512, 64, 512, (u16*)(ws + WS_AUP) + (size_t)i * 512 * 64, 512, tile);
    }
    for (int l = 0; l < 2; ++l) {
        tr_job<2>(P->in[6] + (size_t)l * DM * NIN, DM, NIN, (u16*)(ws + WS_WIN) + (size_t)l * NINP * DM, NINP, tile);
        tr_job<0>(P->in[7] + (size_t)l * DM * DM, DM, DM, (u16*)(ws + WS_WOUT) + (size_t)l * DM * DM, DM, tile);
        tr_job<0>(P->in[13] + (size_t)l * 128 * 512, 128, 512, (u16*)(ws + WS_GUP) + (size_t)l * 512 * 128, 512, tile);
    }
    const size_t gt = (size_t)blockIdx.x * 512 + otid(), gn = (size_t)gridDim.x * 512;
    { unsigned* qz = (unsigned*)(ws + WS_Q); for (size_t i = gt; i < 1024; i += gn) qz[i] = 0u; }
    { const size_t n4 = (size_t)NT * DM / 4, np4 = (size_t)8 * TSEQ * DM / 4;
      const f32x4* xp = (const f32x4*)P->in[0]; const f32x4* xs = (const f32x4*)P->in[1]; u32x2* xb = (u32x2*)(ws + WS_XB);
      for (size_t i = gt; i < n4; i += gn) { const f32x4 v = i < np4 ? xp[i] : xs[i - np4]; u32x2 w = {cvtpk(v[0], v[1]), cvtpk(v[2], v[3])}; xb[i] = w; } }
    { float* rt = (float*)(ws + WS_ROPE);
      for (size_t idx = gt; idx < (size_t)TSEQ * 32; idx += gn) {
          const int t = (int)(idx >> 5), i = (int)(idx & 31);
          const float angf = (float)t * P->inv[i];
          const double x = (double)angf, n = rint(x * 0.63661977236758134308), r = fma(-n, 6.123233995736766e-17, fma(-n, 1.5707963267948966, x));
          const int q = ((int)n) & 3; const double r2 = r * r;
          double sn = r2 * (1.0 / 6227020800.0) - (1.0 / 39916800.0); sn = sn * r2 + (1.0 / 362880.0); sn = sn * r2 - (1.0 / 5040.0); sn = sn * r2 + (1.0 / 120.0); sn = sn * r2 - (1.0 / 6.0); sn = sn * r2 * r + r;
          double cs = r2 * (-1.0 / 87178291200.0) + (1.0 / 479001600.0); cs = cs * r2 - (1.0 / 3628800.0); cs = cs * r2 + (1.0 / 40320.0); cs = cs * r2 - (1.0 / 720.0); cs = cs * r2 + (1.0 / 24.0); cs = cs * r2 - 0.5; cs = cs * r2 + 1.0;
          double s_, c_; if (q == 0) { s_ = sn; c_ = cs; } else if (q == 1) { s_ = cs; c_ = -sn; } else if (q == 2) { s_ = -sn; c_ = -cs; } else { s_ = -cs; c_ = sn; }
          rt[idx * 2 + 0] = (float)c_; rt[idx * 2 + 1] = (float)s_;
      } }
}

__device__ __forceinline__ float wave_sum(float x) {
#pragma unroll
    for (int o = 32; o >= 1; o >>= 1) x += __shfl_xor(x, o);
    return x;
}
template <int MODE>
__device__ __forceinline__ void ln_phase(float* X, u16* Xb, const float* __restrict__ g, const float* __restrict__ b) {
    const int tid_ = otid(), wid = tid_ >> 6, lane = tid_ & 63;
    f32x4 gv[4], bv[4];
#pragma unroll
    for (int j = 0; j < 4; ++j) { gv[j] = *(const f32x4*)(g + j * 256 + lane * 4); bv[j] = *(const f32x4*)(b + j * 256 + lane * 4); }
    for (int row = blockIdx.x * 8 + wid; row < NT; row += gridDim.x * 8) {
        float* xr = X + (size_t)row * DM; f32x4 v[4]; float s = 0.f;
#pragma unroll
        for (int j = 0; j < 4; ++j) { v[j] = *(const f32x4*)(xr + j * 256 + lane * 4); s += v[j][0] + v[j][1] + v[j][2] + v[j][3]; }
        const float mu = wave_sum(s) * (1.f / DM); float q = 0.f;
#pragma unroll
        for (int j = 0; j < 4; ++j) { v[j] = v[j] - mu; q += v[j][0] * v[j][0] + v[j][1] * v[j][1] + v[j][2] * v[j][2] + v[j][3] * v[j][3]; }
        const float rs = 1.0f / sqrtf(wave_sum(q) * (1.f / DM) + LN_EPS_);
#pragma unroll
        for (int j = 0; j < 4; ++j) { const f32x4 y = v[j] * rs * gv[j] + bv[j];
            if (MODE != 1) *(f32x4*)(xr + j * 256 + lane * 4) = y;
            if (MODE != 2) { u32x2 w = {cvtpk(y[0], y[1]), cvtpk(y[2], y[3])}; *(u32x2*)(Xb + (size_t)row * DM + j * 256 + lane * 4) = w; } }
    }
}

__device__ __forceinline__ void rope_phase(u16* PDA, const float* __restrict__ rt) {
    const size_t total = (size_t)NT * 64;
    for (size_t i = (size_t)blockIdx.x * 512 + otid(); i < total; i += (size_t)gridDim.x * 512) {
        const int token = (int)(i >> 6), sub = (int)(i & 63), vec = sub >> 2, f0 = (sub & 3) * 8, pos = token & (TSEQ - 1);
        u16* p = PDA + (size_t)token * DAC + vec * 64 + f0;
        const u32x4 w1 = *(const u32x4*)p, w2 = *(const u32x4*)(p + 32);
        float x1[8], x2[8], o1[8], o2[8]; unpack8(w1, x1); unpack8(w2, x2);
        const float* cs = rt + ((size_t)pos * 32 + f0) * 2;
#pragma unroll
        for (int e = 0; e < 8; ++e) { const float c = cs[2 * e], s = cs[2 * e + 1]; o1[e] = x1[e] * c - x2[e] * s; o2[e] = x2[e] * c + x1[e] * s; }
        *(u32x4*)p = pack8(o1); *(u32x4*)(p + 32) = pack8(o2);
    }
}

namespace att {
constexpr int NW = 8, QBLK = 32, KVBLK = 64, LDQ = DAC;
constexpr float SCALE = 0.125f, THR = 8.f;
constexpr int SHM_V = KVBLK * 128 * 2, SHM_K = KVBLK * 64 * 2;
#define KSWZ(row, colB) ((row) * 128 + ((colB) ^ ((((row) >> 1) & 7) << 4)))
#define SBAR() __builtin_amdgcn_sched_barrier(0)
__device__ __forceinline__ void partialSM(f32x16& p0, f32x16& p1, float& m_reg, float& mn, float& alpha) {
    constexpr float C = SCALE * 1.4426950408889634f;
    float pmax = p0[0];
#pragma unroll
    for (int r = 1; r < 16; ++r) pmax = fmaxf(pmax, p0[r]);
#pragma unroll
    for (int r = 0; r < 16; ++r) pmax = fmaxf(pmax, p1[r]);
    { auto rr = __builtin_amdgcn_permlane32_swap(__float_as_uint(pmax), __float_as_uint(pmax), false, false);
      pmax = fmaxf(__uint_as_float(rr[0]), __uint_as_float(rr[1])); }
    if (__builtin_expect(__all(pmax - m_reg <= THR / SCALE), 1)) { mn = m_reg; alpha = 1.f; }
    else { mn = fmaxf(m_reg, pmax); alpha = __builtin_amdgcn_exp2f((m_reg - mn) * C); m_reg = mn; }
    const float mnC = -mn * C;
#pragma unroll
    for (int r = 0; r < 16; ++r) p0[r] = fmaf(p0[r], C, mnC);
#pragma unroll
    for (int r = 0; r < 16; ++r) p1[r] = fmaf(p1[r], C, mnC);
#pragma unroll
    for (int r = 0; r < 16; ++r) p0[r] = __builtin_amdgcn_exp2f(p0[r]);
}
__device__ __forceinline__ void finishSM(f32x16& p0, f32x16& p1, float alpha, float& l_reg, bf16x8& pa0, bf16x8& pa1, bf16x8& pa2, bf16x8& pa3) {
#pragma unroll
    for (int r = 0; r < 16; ++r) p1[r] = __builtin_amdgcn_exp2f(p1[r]);
    float ps = 0;
#pragma unroll
    for (int r = 0; r < 16; ++r) ps += p0[r];
#pragma unroll
    for (int r = 0; r < 16; ++r) ps += p1[r];
    { auto rr = __builtin_amdgcn_permlane32_swap(__float_as_uint(ps), __float_as_uint(ps), false, false);
      ps = __uint_as_float(rr[0]) + __uint_as_float(rr[1]); }
    l_reg = l_reg * alpha + ps;
#define PK4(P, BASE, OUT) do { unsigned a0 = cvtpk(P[BASE + 0], P[BASE + 1]), a1 = cvtpk(P[BASE + 2], P[BASE + 3]);   \
    unsigned b0 = cvtpk(P[BASE + 4], P[BASE + 5]), b1 = cvtpk(P[BASE + 6], P[BASE + 7]);                              \
    auto r0 = __builtin_amdgcn_permlane32_swap(a0, b0, false, false); auto r1 = __builtin_amdgcn_permlane32_swap(a1, b1, false, false); \
    u32x4 w = {r0[0], r1[0], r0[1], r1[1]}; OUT = *reinterpret_cast<bf16x8*>(&w); } while (0)
    PK4(p0, 0, pa0); PK4(p0, 8, pa1); PK4(p1, 0, pa2); PK4(p1, 8, pa3);
#undef PK4
}
__device__ __forceinline__ void qkt(f32x16& p0, f32x16& p1, const char* Ks, const bf16x8* qr, int r32, int hi) {
    p0 = f32x16{}; p1 = f32x16{};
#pragma unroll
    for (int d0 = 0; d0 < 4; ++d0) { const int cb = (d0 * 16 + hi * 8) * 2;
        const bf16x8 b0 = *reinterpret_cast<const bf16x8*>(Ks + KSWZ(r32, cb));
        const bf16x8 b1 = *reinterpret_cast<const bf16x8*>(Ks + KSWZ(32 + r32, cb));
        p0 = __builtin_amdgcn_mfma_f32_32x32x16_bf16(b0, qr[d0], p0, 0, 0, 0);
        p1 = __builtin_amdgcn_mfma_f32_32x32x16_bf16(b1, qr[d0], p1, 0, 0, 0); }
}
__device__ __forceinline__ int v_st(int k, int c) { const int kk = (k & ~0xC) | ((k & 4) << 1) | ((k & 8) >> 1); return ((kk >> 3) * 4 + (c >> 5)) * 512 + ((kk & 7) * 32 + (c & 31)) * 2; }
__device__ __forceinline__ int v_rd_base(int lane) { return ((lane & 3) << 3) | (((lane >> 2) & 3) << 6) | (((lane >> 4) & 1) << 5) | (((lane >> 5) & 1) << 8); }
constexpr int v_rd_off(int d0, int ks, int half) { return d0 * 512 + ks * 4096 + half * 2048; }
template <int OFF> __device__ __forceinline__ s16x4 tr_read(int vb) {
    s16x4 r; asm volatile("ds_read_b64_tr_b16 %0, %1 offset:%2" : "=&v"(r) : "v"(vb), "i"(OFF) : "memory"); return r;
}
template <int D0> __device__ __forceinline__ void pv_one(f32x16& od, int vb, bf16x8 pa0, bf16x8 pa1, bf16x8 pa2, bf16x8 pa3) {
    const s16x4 l0 = tr_read<v_rd_off(D0, 0, 0)>(vb), h0 = tr_read<v_rd_off(D0, 0, 1)>(vb), l1 = tr_read<v_rd_off(D0, 1, 0)>(vb), h1 = tr_read<v_rd_off(D0, 1, 1)>(vb);
    const s16x4 l2 = tr_read<v_rd_off(D0, 2, 0)>(vb), h2 = tr_read<v_rd_off(D0, 2, 1)>(vb), l3 = tr_read<v_rd_off(D0, 3, 0)>(vb), h3 = tr_read<v_rd_off(D0, 3, 1)>(vb);
    asm volatile("s_waitcnt lgkmcnt(0)" ::: "memory"); SBAR();
#define PK(L, H) (bf16x8){L[0], L[1], L[2], L[3], H[0], H[1], H[2], H[3]}
    od = __builtin_amdgcn_mfma_f32_32x32x16_bf16(pa0, PK(l0, h0), od, 0, 0, 0);
    od = __builtin_amdgcn_mfma_f32_32x32x16_bf16(pa1, PK(l1, h1), od, 0, 0, 0);
    od = __builtin_amdgcn_mfma_f32_32x32x16_bf16(pa2, PK(l2, h2), od, 0, 0, 0);
    od = __builtin_amdgcn_mfma_f32_32x32x16_bf16(pa3, PK(l3, h3), od, 0, 0, 0);
#undef PK
}
__device__ __forceinline__ void pv_d0(f32x16* o, int vb, bf16x8 pa0, bf16x8 pa1, bf16x8 pa2, bf16x8 pa3) {
    pv_one<0>(o[0], vb, pa0, pa1, pa2, pa3); pv_one<1>(o[1], vb, pa0, pa1, pa2, pa3); pv_one<2>(o[2], vb, pa0, pa1, pa2, pa3); pv_one<3>(o[3], vb, pa0, pa1, pa2, pa3);
}

__device__ __forceinline__ void attn_pass(const u16* __restrict__ Qb, const u16* __restrict__ Kh, const u16* __restrict__ Vh, char* lds, f32x16* o, float& l_out) {
    const int tid = otid(), wid = tid >> 6, lane = tid & 63, r32 = lane & 31, hi = lane >> 5, cp = wid >> 2, wq = wid & 3;
    char* V_lds = lds; char* K_lds = lds + 2 * SHM_V;
    float* wsl = (float*)(lds + 2 * SHM_V + 4 * SHM_K) + wid * 64; float* al_l = wsl + 32;
    float m_reg = -1e30f, l_reg = 0;
#pragma unroll
    for (int d = 0; d < 4; ++d) o[d] = f32x16{};
    bf16x8 qr[4];
    const u16* Qw = Qb + (size_t)(wq * QBLK + r32) * LDQ + cp * 64 + hi * 8;
#pragma unroll
    for (int d0 = 0; d0 < 4; ++d0) qr[d0] = *reinterpret_cast<const bf16x8*>(Qw + d0 * 16);
    const int sr = tid >> 4, sc = (tid & 15) * 8, vst0 = v_st(sr, sc), vst1 = v_st(32 + sr, sc);
    const int kr = tid >> 3, kcB = (tid & 7) * 16, kst = KSWZ(kr, kcB);
    const int vb0 = (int)(uintptr_t)V_lds + v_rd_base(lane);
    struct { bf16x8 vs0, vs1, ks0, ks1; } sr_[2];
    const char* Kc = K_lds + cp * SHM_K;
#define SLOAD(i, k0) do { sr_[i].vs0 = *reinterpret_cast<const bf16x8*>(&Vh[(size_t)((k0) + sr) * LDQ + sc]); sr_[i].vs1 = *reinterpret_cast<const bf16x8*>(&Vh[(size_t)((k0) + 32 + sr) * LDQ + sc]); \
    sr_[i].ks0 = *reinterpret_cast<const bf16x8*>(&Kh[(size_t)((k0) + kr) * LDQ + (tid & 7) * 8]); sr_[i].ks1 = *reinterpret_cast<const bf16x8*>(&Kh[(size_t)((k0) + kr) * LDQ + 64 + (tid & 7) * 8]); } while (0)
#define SWRITE(b, i) do { *(bf16x8*)(V_lds + (b) * SHM_V + vst0) = sr_[i].vs0; *(bf16x8*)(V_lds + (b) * SHM_V + vst1) = sr_[i].vs1; \
    *(bf16x8*)(K_lds + (b) * 2 * SHM_K + kst) = sr_[i].ks0; *(bf16x8*)(K_lds + (b) * 2 * SHM_K + SHM_K + kst) = sr_[i].ks1; } while (0)
#define SWAIT() asm volatile("s_waitcnt vmcnt(4)" ::: "memory")
#define RESC(a) do { if (__any((a) < 1.f)) { if (hi == 0) al_l[r32] = (a); asm volatile("s_waitcnt lgkmcnt(0)" ::: "memory"); \
    _Pragma("unroll") for (int d = 0; d < 4; ++d) _Pragma("unroll") for (int r = 0; r < 16; ++r) o[d][r] *= al_l[crow(r, hi)]; } } while (0)
    f32x16 pA0, pA1, pB0, pB1; float mnA, mnB, alA, alB; bf16x8 pa0, pa1, pa2, pa3; constexpr int NTL = TSEQ / KVBLK;
    constexpr int SE = 0, SO = 1;
    asm volatile("s_waitcnt vmcnt(0)" ::: "memory");
    SLOAD(SE, 0); asm volatile("s_waitcnt vmcnt(0)" ::: "memory"); SWRITE(0, SE); __syncthreads();
    qkt(pA0, pA1, Kc, qr, r32, hi); partialSM(pA0, pA1, m_reg, mnA, alA);
    SLOAD(SO, KVBLK); SLOAD(SE, 2 * KVBLK);
    SWAIT(); SWRITE(1, SO); __syncthreads();
    for (int j = 1; j + 1 < NTL; j += 2) {
        SBAR(); qkt(pB0, pB1, Kc + 2 * SHM_K, qr, r32, hi);
        finishSM(pA0, pA1, alA, l_reg, pa0, pa1, pa2, pa3); SBAR();
        SLOAD(SO, (j + 2) * KVBLK); SBAR();
        pv_d0(o, vb0, pa0, pa1, pa2, pa3); partialSM(pB0, pB1, m_reg, mnB, alB);
        __syncthreads(); SWAIT(); SWRITE(0, SE);
        RESC(alB); __syncthreads();
        SBAR(); qkt(pA0, pA1, Kc, qr, r32, hi);
        finishSM(pB0, pB1, alB, l_reg, pa0, pa1, pa2, pa3); SBAR();
        if (j + 3 < NTL) SLOAD(SE, (j + 3) * KVBLK); SBAR();
        pv_d0(o, vb0 + SHM_V, pa0, pa1, pa2, pa3); partialSM(pA0, pA1, m_reg, mnA, alA);
        __syncthreads(); SWAIT(); SWRITE(1, SO);
        RESC(alA); __syncthreads();
    }
    SBAR(); qkt(pB0, pB1, Kc + 2 * SHM_K, qr, r32, hi);
    finishSM(pA0, pA1, alA, l_reg, pa0, pa1, pa2, pa3); SBAR();
    pv_d0(o, vb0, pa0, pa1, pa2, pa3); partialSM(pB0, pB1, m_reg, mnB, alB);
    __syncthreads(); RESC(alB);
    finishSM(pB0, pB1, alB, l_reg, pa0, pa1, pa2, pa3); SBAR();
    pv_d0(o, vb0 + SHM_V, pa0, pa1, pa2, pa3);
    l_out = l_reg;
#undef SLOAD
#undef SWRITE
#undef SWAIT
#undef RESC
}
}

__device__ __forceinline__ void attn_phase(KP P, int l, unsigned char* shm) {
    const int tid = otid(), wid = tid >> 6, lane = tid & 63, r32 = lane & 31, hi = lane >> 5, cp = wid >> 2, wq = wid & 3;
    const u16* PDA = (const u16*)(P->ws + WS_PDA); u16* PDAw = (u16*)(P->ws + WS_PDA);
    float* li_l = (float*)(shm + 2 * att::SHM_V + 4 * att::SHM_K) + wid * 64;
    float* XCH = (float*)shm;
    const float lam_init = 0.8f - 0.6f * expf(-0.3f * (float)l);
    float lam;
    { const float* dl = P->in[19] + l * 256; const float p1 = wave_sum(dl[lane] * dl[64 + lane]), p2 = wave_sum(dl[128 + lane] * dl[192 + lane]); lam = expf(p1) - expf(p2) + lam_init; }
    float sg[4];
#pragma unroll
    for (int d0 = 0; d0 < 4; ++d0) sg[d0] = P->in[20][l * 128 + d0 * 32 + r32] * (1.f - lam_init);
    unsigned* qhead = (unsigned*)(P->ws + WS_Q) + l * 128;
    volatile int* slot = (volatile int*)(shm + 2 * att::SHM_V + 4 * att::SHM_K + 2048 + 64);
    const unsigned xcc = ((unsigned)__builtin_amdgcn_s_getreg((3 << 11) | 20)) & 7u;
    for (;;) {
        __syncthreads();
        if (tid == 0) { int item = -1;
            for (unsigned k = 0; k < 8u; ++k) { const unsigned qx = (xcc + k) & 7u; const unsigned idx = __hip_atomic_fetch_add(qhead + qx * 16, 1u, __ATOMIC_RELAXED, __HIP_MEMORY_SCOPE_AGENT);
                if (idx < 384u) { item = (int)(qx * 384u + idx); break; } }
            *slot = item; }
        __syncthreads();
        const int item = *slot; if (item < 0) break;
        const int qx = item / 384, idx = item - qx * 384;
        const int bh = (idx >> 6) * 8 + qx, qb = idx & 63, b = bh >> 2, h = bh & 3;
        const size_t tok0 = (size_t)b * TSEQ;
        f32x16 o[4]; float l_reg; float rli[16];
        __syncthreads();
        att::attn_pass(PDA + (tok0 + qb * 128) * DAC + h * 128, PDA + tok0 * DAC + 512 + h * 128, PDA + tok0 * DAC + 1024 + h * 128, (char*)shm, o, l_reg);
        asm volatile("s_waitcnt lgkmcnt(0)" ::: "memory");
        if (hi == 0) li_l[r32] = l_reg; asm volatile("s_waitcnt lgkmcnt(0)" ::: "memory");
#pragma unroll
        for (int r = 0; r < 16; ++r) rli[r] = 1.0f / li_l[crow(r, hi)];
        __syncthreads();
        if (cp == 1) {
#pragma unroll
            for (int r = 0; r < 16; ++r)
#pragma unroll
                for (int d0 = 0; d0 < 4; ++d0) XCH[((wq * 16 + r) * 4 + d0) * 64 + lane] = o[d0][r] * rli[r];
        }
        __syncthreads();
        if (cp == 0) {
            u16* yb = PDAw + (tok0 + qb * 128 + wq * 32 + 4 * hi) * DAC + h * 128 + r32; asm volatile("" : "+v"(yb));
#pragma unroll
            for (int r = 0; r < 16; ++r) {
                float v[4], ss = 0.f;
#pragma unroll
                for (int d0 = 0; d0 < 4; ++d0) { const float o1n = XCH[((wq * 16 + r) * 4 + d0) * 64 + lane];
                    v[d0] = o[d0][r] * rli[r] - lam * o1n; ss += v[d0] * v[d0]; }
#pragma unroll
                for (int m = 16; m >= 1; m >>= 1) ss += __shfl_xor(ss, m);
                const float rs = 1.0f / sqrtf(ss * (1.f / 128.f) + SUBLN_EPS_);
                u16* yr = yb + crow(r, 0) * DAC;
#pragma unroll
                for (int d0 = 0; d0 < 4; ++d0) yr[d0 * 32] = f2bf(v[d0] * rs * sg[d0]);
            }
        }
    }
}

__device__ __forceinline__ float allred4(float x) {
    { auto rr = __builtin_amdgcn_permlane16_swap(__float_as_uint(x), __float_as_uint(x), false, false); x = __uint_as_float(rr[0]) + __uint_as_float(rr[1]); }
    { auto rr = __builtin_amdgcn_permlane32_swap(__float_as_uint(x), __float_as_uint(x), false, false); x = __uint_as_float(rr[0]) + __uint_as_float(rr[1]); }
    return x;
}
#define DPPX(J) " row_newbcast:" #J " row_mask:0xf bank_mask:0xf\n"
#define SC_FMA(J) "v_fmac_f32_dpp %[acc0], %[x], %[s" #J "]" DPPX(J)
#define SC_FMB(J) "v_fmac_f32_dpp %[acc1], %[x], %[s" #J "]" DPPX(J)
#define SC_MUL(J) "v_mul_f32_dpp %[s" #J "], %[w], %[s" #J "]" DPPX(J)
#define SC_F1(J) "v_fmac_f32_dpp %[s" #J "], %[bb], %[sa]" DPPX(J)
#define SC_F2(J) "v_fmac_f32_dpp %[s" #J "], %[km], %[v]" DPPX(J)
#define SC_OA(J) "v_fmac_f32_dpp %[o0], %[r], %[s" #J "]" DPPX(J)
#define SC_OB(J) "v_fmac_f32_dpp %[o1], %[r], %[s" #J "]" DPPX(J)
#define ALL16(M) M(0) M(1) M(2) M(3) M(4) M(5) M(6) M(7) M(8) M(9) M(10) M(11) M(12) M(13) M(14) M(15)
#define EVEN8(M) M(0) M(2) M(4) M(6) M(8) M(10) M(12) M(14)
#define ODD8(M) M(1) M(3) M(5) M(7) M(9) M(11) M(13) M(15)
#define SIN_(J) [s##J] "v"(s##J),
#define SIO_(J) [s##J] "+v"(s##J),

__device__ __forceinline__ float fsig(float x) { return __builtin_amdgcn_rcpf(1.f + __expf(-x)); }
__device__ __forceinline__ void scan_load(int jn, int p, int lane, int b, int h, int d, const u16* __restrict__ PRW, u32x4 (&raw)[5][3]) {
    const int sl = lane >> 3, g_ = lane & 7, s = 8 * p + sl, tau = 32 * jn + s, t = d ? (TSEQ - 1 - tau) : tau; const size_t token = (size_t)b * TSEQ + t;
    const int cbase[5] = {64 * h, 512 + 64 * h, 1024 + 64 * h, 1536 + 64 * d, 1664 + 64 * d};
#pragma unroll
    for (int vec = 0; vec < 5; ++vec) {
        const u16* q = PRW + token * RWC + cbase[vec] + 8 * g_;
        raw[vec][0] = *(const u32x4*)q; raw[vec][1] = (u32x4){0u, 0u, 0u, 0u}; raw[vec][2] = (u32x4){0u, 0u, 0u, 0u};
        if (t > 0) raw[vec][1] = *(const u32x4*)(q - RWC); if (t < TSEQ - 1) raw[vec][2] = *(const u32x4*)(q + RWC);
    }
}
__device__ __forceinline__ void scan_produce(const u32x4 (&raw)[5][3], int jn, int p, int lane, int b, int h, int d, const u16* __restrict__ PRW, float* RK, unsigned char* ob, u16* WDXp, u16* ADXp,
                                             const float* MU_, const u16* Bw_, const u16* Ba_, const float (&bw)[4], const float (&ba)[4],
                                             const float* kkp_, const float* kap_, const float* rkp_) {
    float* R_ = (float*)ob; float* V_ = R_ + 2048; float* W_ = V_ + 2048; float* NKK_ = W_ + 2048; float* KM_ = NKK_ + 2048; float* BB_ = KM_ + 2048;
    const int sl = lane >> 3, g_ = lane & 7, s = 8 * p + sl, tau = 32 * jn + s, t = d ? (TSEQ - 1 - tau) : tau; const size_t token = (size_t)b * TSEQ + t;
    const int cbase[5] = {64 * h, 512 + 64 * h, 1024 + 64 * h, 1536 + 64 * d, 1664 + 64 * d};
    bf16x8 bfw[4][2], bfa[4][2];
    { const u16* Bw = Bw_; const u16* Ba = Ba_; asm volatile("" : "+v"(Bw), "+v"(Ba));
#pragma unroll
      for (int nb = 0; nb < 4; ++nb)
#pragma unroll
          for (int ks = 0; ks < 2; ++ks) { bfw[nb][ks] = *reinterpret_cast<const bf16x8*>(Bw + nb * 16 * 64 + 32 * ks); bfa[nb][ks] = *reinterpret_cast<const bf16x8*>(Ba + nb * 16 * 64 + 32 * ks); } }
#pragma unroll
    for (int vec = 0; vec < 5; ++vec) {
        float c[8], pv[8], nx[8], x[8]; unpack8(raw[vec][0], c); unpack8(raw[vec][1], pv); unpack8(raw[vec][2], nx);
#pragma unroll
        for (int e = 0; e < 8; ++e) { const float mp = MU_[vec * 128 + 8 * g_ + e], mn = MU_[vec * 128 + 64 + 8 * g_ + e]; x[e] = c[e] + mp * (pv[e] - c[e]) + mn * (nx[e] - c[e]); }
        if (vec < 3) { float* dst = (vec == 0 ? R_ : vec == 1 ? KM_ : V_) + s * 64 + 8 * g_;
            *(f32x4*)dst = (f32x4){x[0], x[1], x[2], x[3]}; *(f32x4*)(dst + 4) = (f32x4){x[4], x[5], x[6], x[7]}; }
        else { if (vec == 3) {
#pragma unroll
                for (int e = 0; e < 8; ++e) x[e] = 1.f - 2.f * __builtin_amdgcn_rcpf(1.f + __expf(2.f * x[e])); }
            *(u32x4*)((vec == 3 ? WDXp : ADXp) + sl * 72 + 8 * g_) = pack8(x); }
    }
    asm volatile("s_waitcnt lgkmcnt(0)" ::: "memory");
    { const int fr = lane & 15, fq = lane >> 4;
      bf16x8 aw[2], aa[2];
#pragma unroll
      for (int ks = 0; ks < 2; ++ks) { aw[ks] = *reinterpret_cast<const bf16x8*>(WDXp + fr * 72 + 32 * ks + 8 * fq); aa[ks] = *reinterpret_cast<const bf16x8*>(ADXp + fr * 72 + 32 * ks + 8 * fq); }
#pragma unroll
      for (int nb = 0; nb < 4; ++nb) {
          f32x4 cw = {0.f, 0.f, 0.f, 0.f}, ca = {0.f, 0.f, 0.f, 0.f};
#pragma unroll
          for (int ks = 0; ks < 2; ++ks) { cw = __builtin_amdgcn_mfma_f32_16x16x32_bf16(aw[ks], bfw[nb][ks], cw, 0, 0, 0); ca = __builtin_amdgcn_mfma_f32_16x16x32_bf16(aa[ks], bfa[nb][ks], ca, 0, 0, 0); }
          if (fq < 2) {
#pragma unroll
              for (int jj = 0; jj < 4; ++jj) { const int srow = 8 * p + 4 * fq + jj, n = 16 * nb + fr;
                  W_[srow * 64 + n] = __expf(-0.60653065971263342f * fsig(cw[jj] + bw[nb]));
                  BB_[srow * 64 + n] = fsig(ca[jj] + ba[nb]); } }
      } }
    asm volatile("s_waitcnt lgkmcnt(0)" ::: "memory");
    { float k[8], a[8], r[8], kkr[8], ss = 0.f, kkc[8], kac[8], rkc[8];
      { const float* kkp = kkp_; const float* kap = kap_; const float* rkp2 = rkp_; asm volatile("" : "+v"(kkp), "+v"(kap), "+v"(rkp2));
        const f32x4 q0 = *(const f32x4*)kkp, q1 = *(const f32x4*)(kkp + 4), q2 = *(const f32x4*)kap, q3 = *(const f32x4*)(kap + 4), q4 = *(const f32x4*)rkp2, q5 = *(const f32x4*)(rkp2 + 4);
#pragma unroll
        for (int e = 0; e < 4; ++e) { kkc[e] = q0[e]; kkc[4 + e] = q1[e]; kac[e] = q2[e]; kac[4 + e] = q3[e]; rkc[e] = q4[e]; rkc[4 + e] = q5[e]; } }
      { const f32x4 k0 = *(const f32x4*)(KM_ + s * 64 + 8 * g_), k1 = *(const f32x4*)(KM_ + s * 64 + 8 * g_ + 4), a0 = *(const f32x4*)(BB_ + s * 64 + 8 * g_), a1 = *(const f32x4*)(BB_ + s * 64 + 8 * g_ + 4),
                    r0 = *(const f32x4*)(R_ + s * 64 + 8 * g_), r1 = *(const f32x4*)(R_ + s * 64 + 8 * g_ + 4);
#pragma unroll
        for (int e = 0; e < 4; ++e) { k[e] = k0[e]; k[4 + e] = k1[e]; a[e] = a0[e]; a[4 + e] = a1[e]; r[e] = r0[e]; r[4 + e] = r1[e]; } }
#pragma unroll
      for (int e = 0; e < 8; ++e) { kkr[e] = k[e] * kkc[e]; ss += kkr[e] * kkr[e]; }
      ss += __shfl_xor(ss, 1); ss += __shfl_xor(ss, 2); ss += __shfl_xor(ss, 4);
      const float inv = __builtin_amdgcn_rsqf(fmaxf(ss, 1e-24f));
      float nk[8], bb[8], km[8], rkp = 0.f;
#pragma unroll
      for (int e = 0; e < 8; ++e) { const float kk = kkr[e] * inv; nk[e] = -kk; bb[e] = kk * a[e]; km[e] = k[e] * (1.f + (a[e] - 1.f) * kac[e]); rkp += r[e] * km[e] * rkc[e]; }
      rkp += __shfl_xor(rkp, 1); rkp += __shfl_xor(rkp, 2); rkp += __shfl_xor(rkp, 4);
      *(f32x4*)(NKK_ + s * 64 + 8 * g_) = (f32x4){nk[0], nk[1], nk[2], nk[3]}; *(f32x4*)(NKK_ + s * 64 + 8 * g_ + 4) = (f32x4){nk[4], nk[5], nk[6], nk[7]};
      *(f32x4*)(BB_ + s * 64 + 8 * g_) = (f32x4){bb[0], bb[1], bb[2], bb[3]}; *(f32x4*)(BB_ + s * 64 + 8 * g_ + 4) = (f32x4){bb[4], bb[5], bb[6], bb[7]};
      *(f32x4*)(KM_ + s * 64 + 8 * g_) = (f32x4){km[0], km[1], km[2], km[3]}; *(f32x4*)(KM_ + s * 64 + 8 * g_ + 4) = (f32x4){km[4], km[5], km[6], km[7]};
      if (g_ == 0) RK[((size_t)d * NT + token) * 8 + h] = rkp; }
}
__device__ __forceinline__ void scan_writeout(int jo, int p, int lane, int b, int h, int d, const float* O_, u16* OD) {
    const int sl = lane >> 3, g_ = lane & 7, s = 8 * p + sl, tau = 32 * jo + s, t = d ? (TSEQ - 1 - tau) : tau; const size_t token = (size_t)b * TSEQ + t;
    float f[8]; const f32x4 a0 = *(const f32x4*)(O_ + s * 64 + 8 * g_), a1 = *(const f32x4*)(O_ + s * 64 + 8 * g_ + 4);
#pragma unroll
    for (int e = 0; e < 4; ++e) { f[e] = a0[e]; f[4 + e] = a1[e]; }
    *(u32x4*)(OD + token * DM + d * 512 + 64 * h + 8 * g_) = pack8(f);
}

__device__ __forceinline__ void scan_phase(KP P, int l, unsigned char* shm) {
    const int tid = otid(), wid = tid >> 6, lane = tid & 63;
    constexpr int NCH = TSEQ / 32, OB_STRIDE = 49152, OO_BASE = 98304, PT_BASE = 114688, MU_BASE = 133120;
    float* MU_ = (float*)(shm + MU_BASE);
    const u16* PRW = (const u16*)(P->ws + WS_PRW); u16* OD = (u16*)(P->ws + WS_XB); float* RK = (float*)(P->ws + WS_RK);
    const int p = wid & 3; u16* WDXp = (u16*)(shm + PT_BASE + p * 4608); u16* ADXp = WDXp + 16 * 72;
    for (int u = blockIdx.x; u < 192; u += gridDim.x) {
        const int b = u >> 4, h = (u >> 1) & 7, d = u & 1;
        __syncthreads();
        for (int i = tid; i < 640; i += 512) { const int vec = i >> 7, which = (i >> 6) & 1, n = i & 63;
            const int cb = vec == 0 ? 64 * h : vec == 1 ? 512 + 64 * h : vec == 2 ? 1024 + 64 * h : vec == 3 ? 1536 + 64 * d : 1664 + 64 * d;
            MU_[i] = P->in[8][(size_t)(l * 2 + which) * RWC + cb + n]; }
        float bw[4], ba[4]; const u16* Bw; const u16* Ba; const float* kkp; const float* kap; const float* rkp;
        { const int fr = lane & 15, fq = lane >> 4, g_ = lane & 7;
          Bw = (const u16*)(P->ws + WS_WUP) + ((size_t)(l * 2 + d) * 512 + 64 * h + fr) * 64 + 8 * fq;
          Ba = (const u16*)(P->ws + WS_AUP) + ((size_t)(l * 2 + d) * 512 + 64 * h + fr) * 64 + 8 * fq;
#pragma unroll
          for (int nb = 0; nb < 4; ++nb) {
              bw[nb] = P->in[10][(size_t)(l * 2 + d) * 512 + 64 * h + 16 * nb + fr]; ba[nb] = P->in[12][(size_t)(l * 2 + d) * 512 + 64 * h + 16 * nb + fr]; }
          kkp = P->in[14] + l * 512 + 64 * h + 8 * g_; kap = P->in[15] + l * 512 + 64 * h + 8 * g_; rkp = P->in[16] + l * 512 + 64 * h + 8 * g_; }
        float s0 = 0, s1 = 0, s2 = 0, s3 = 0, s4 = 0, s5 = 0, s6 = 0, s7 = 0, s8 = 0, s9 = 0, s10 = 0, s11 = 0, s12 = 0, s13 = 0, s14 = 0, s15 = 0;
        __syncthreads();
        u32x4 raw[5][3];
        if (wid >= 4) { scan_load(0, p, lane, b, h, d, PRW, raw); scan_produce(raw, 0, p, lane, b, h, d, PRW, RK, shm, WDXp, ADXp, MU_, Bw, Ba, bw, ba, kkp, kap, rkp); scan_load(1, p, lane, b, h, d, PRW, raw); }
        __syncthreads();
        for (int j = 0; j < NCH; ++j) {
            unsigned char* ob = shm + (j & 1) * OB_STRIDE; float* O_ = (float*)(shm + OO_BASE + (j & 1) * 8192);
            if (wid < 4) {
                const float* R_ = (const float*)ob; const float* V_ = R_ + 2048; const float* W_ = V_ + 2048; const float* NKK_ = W_ + 2048; const float* KM_ = NKK_ + 2048; const float* BB_ = KM_ + 2048;
                float pn[4], pw[4], pb[4], pk[4], pr[4], pv[4];
#pragma unroll
                for (int i = 0; i < 4; ++i) { pn[i] = NKK_[i * 64 + lane]; pw[i] = W_[i * 64 + lane]; pb[i] = BB_[i * 64 + lane]; pk[i] = KM_[i * 64 + lane]; pr[i] = R_[i * 64 + lane]; pv[i] = V_[i * 64 + 16 * wid + (lane & 15)]; }
                for (int st = 0; st < 32; st += 4) {
#pragma unroll
                    for (int i = 0; i < 4; ++i) {
                        const float cn = pn[i], cw = pw[i], cb_ = pb[i], ck = pk[i], cr = pr[i], cv = pv[i];
                        { const int sn = st + 4 + i;
                          pn[i] = NKK_[sn * 64 + lane]; pw[i] = W_[sn * 64 + lane]; pb[i] = BB_[sn * 64 + lane]; pk[i] = KM_[sn * 64 + lane]; pr[i] = R_[sn * 64 + lane]; pv[i] = V_[sn * 64 + 16 * wid + (lane & 15)]; }
                        float sa0 = 0.f, sa1 = 0.f;
                        asm volatile("s_nop 1\n" EVEN8(SC_FMA) ODD8(SC_FMB) "s_nop 1\n"
                                     : [acc0] "+v"(sa0), [acc1] "+v"(sa1) : ALL16(SIN_) [x] "v"(cn));
                        const float sa = allred4(sa0 + sa1);
                        float o0 = 0.f, o1 = 0.f;
                        asm volatile("s_nop 1\n" ALL16(SC_MUL) ALL16(SC_F1) ALL16(SC_F2) EVEN8(SC_OA) ODD8(SC_OB) "s_nop 1\n"
                                     : ALL16(SIO_) [o0] "+v"(o0), [o1] "+v"(o1)
                                     : [sa] "v"(sa), [v] "v"(cv), [w] "v"(cw), [bb] "v"(cb_), [km] "v"(ck), [r] "v"(cr));
                        const float oo = allred4(o0 + o1);
                        O_[(st + i) * 64 + 16 * wid + (lane & 15)] = oo;
                    }
                }
            } else {
                if (j + 1 < NCH) scan_produce(raw, j + 1, p, lane, b, h, d, PRW, RK, shm + ((j + 1) & 1) * OB_STRIDE, WDXp, ADXp, MU_, Bw, Ba, bw, ba, kkp, kap, rkp);
                if (j + 2 < NCH) scan_load(j + 2, p, lane, b, h, d, PRW, raw);
                if (j >= 1) scan_writeout(j - 1, p, lane, b, h, d, (const float*)(shm + OO_BASE + ((j - 1) & 1) * 8192), OD);
            }
            __syncthreads();
        }
        if (wid >= 4) scan_writeout(NCH - 1, p, lane, b, h, d, (const float*)(shm + OO_BASE + ((NCH - 1) & 1) * 8192), OD);
    }
}

__device__ __forceinline__ float red32(float x) {
#pragma unroll
    for (int m = 16; m >= 1; m >>= 1) x += __shfl_xor(x, m);
    return x;
}
__device__ __forceinline__ void post_phase(KP P, int l, unsigned char* shm) {
    const int tid = otid(), wid = tid >> 6, lane = tid & 63, r32 = lane & 31, hi = lane >> 5, h = wid;
    u16* GS = (u16*)shm;
    float* G = (float*)(shm + 17408) + wid * (64 * 68);
    const u16* PRW = (const u16*)(P->ws + WS_PRW); const u16* PDA = (const u16*)(P->ws + WS_PDA); const float* RK = (const float*)(P->ws + WS_RK); u16* Y = (u16*)(P->ws + WS_XB);
    const u16* gup0 = (const u16*)(P->ws + WS_GUP) + ((size_t)l * 512 + 64 * h + r32) * 128 + 8 * hi;
    const int s_ = tid >> 3, g_ = tid & 7, ls = lane >> 3, lg = lane & 7;
    const float* mgp0 = P->in[8] + (size_t)(l * 2 + 0) * RWC + 1792 + 16 * g_;
    float gng[8], gnb[8], mvp[8], mvn[8];
#pragma unroll
    for (int e = 0; e < 8; ++e) { const int c = 64 * h + 8 * lg + e; gng[e] = P->in[17][l * 512 + c]; gnb[e] = P->in[18][l * 512 + c];
        mvp[e] = P->in[8][(size_t)(l * 2 + 0) * RWC + 1024 + c]; mvn[e] = P->in[8][(size_t)(l * 2 + 1) * RWC + 1024 + c]; }
    for (int it = blockIdx.x; it < NT / 64; it += gridDim.x) {
        const size_t tok0 = (size_t)it * 64;
        __syncthreads();
        { const size_t token = tok0 + s_; const int t = (int)(token & (TSEQ - 1));
          const float* mgp = mgp0; asm volatile("" : "+v"(mgp)); const float* mgn = mgp + RWC;
#pragma unroll
          for (int hf = 0; hf < 2; ++hf) {
              const u16* p = PRW + token * RWC + 1792 + 16 * g_ + 8 * hf;
              const u32x4 wc = *(const u32x4*)p; u32x4 wp = {0u, 0u, 0u, 0u}, wn = {0u, 0u, 0u, 0u};
              if (t > 0) wp = *(const u32x4*)(p - RWC); if (t < TSEQ - 1) wn = *(const u32x4*)(p + RWC);
              float c[8], pv[8], nx[8], x[8]; unpack8(wc, c); unpack8(wp, pv); unpack8(wn, nx);
#pragma unroll
              for (int e = 0; e < 8; ++e) { const float xs = c[e] + mgp[8 * hf + e] * (pv[e] - c[e]) + mgn[8 * hf + e] * (nx[e] - c[e]); x[e] = fsig(xs); }
              *(u32x4*)(GS + s_ * 136 + 16 * g_ + 8 * hf) = pack8(x);
          } }
        __syncthreads();
        { f32x16 acc[2][2];
#pragma unroll
          for (int mb = 0; mb < 2; ++mb)
#pragma unroll
              for (int nb = 0; nb < 2; ++nb) acc[mb][nb] = f32x16{};
          const u16* gup = gup0; asm volatile("" : "+v"(gup));
#pragma unroll
          for (int ks = 0; ks < 8; ++ks) {
              const bf16x8 b0 = *reinterpret_cast<const bf16x8*>(gup + 16 * ks), b1 = *reinterpret_cast<const bf16x8*>(gup + 32 * 128 + 16 * ks);
#pragma unroll
              for (int mb = 0; mb < 2; ++mb) { const bf16x8 a = *reinterpret_cast<const bf16x8*>(GS + (32 * mb + r32) * 136 + 16 * ks + 8 * hi);
                  acc[mb][0] = __builtin_amdgcn_mfma_f32_32x32x16_bf16(a, b0, acc[mb][0], 0, 0, 0); acc[mb][1] = __builtin_amdgcn_mfma_f32_32x32x16_bf16(a, b1, acc[mb][1], 0, 0, 0); } }
#pragma unroll
          for (int mb = 0; mb < 2; ++mb)
#pragma unroll
              for (int nb = 0; nb < 2; ++nb)
#pragma unroll
                  for (int i = 0; i < 16; ++i) G[(32 * mb + crow(i, hi)) * 68 + 32 * nb + r32] = acc[mb][nb][i]; }
        asm volatile("s_waitcnt lgkmcnt(0)" ::: "memory");
#pragma unroll 2
        for (int q = 0; q < 8; ++q) {
            const int srow = 8 * q + ls; const size_t token = tok0 + srow; const int t = (int)(token & (TSEQ - 1));
            const u32x4 wo0 = *(const u32x4*)(Y + token * DM + 64 * h + 8 * lg), wo1 = *(const u32x4*)(Y + token * DM + 512 + 64 * h + 8 * lg);
            const u32x4 yda = *(const u32x4*)(PDA + token * DAC + 64 * h + 8 * lg);
            const u16* pvp = PRW + token * RWC + 1024 + 64 * h + 8 * lg;
            const u32x4 wc = *(const u32x4*)pvp; u32x4 wp = {0u, 0u, 0u, 0u}, wn = {0u, 0u, 0u, 0u};
            if (t > 0) wp = *(const u32x4*)(pvp - RWC); if (t < TSEQ - 1) wn = *(const u32x4*)(pvp + RWC);
            const float rk = RK[token * 8 + h] + RK[((size_t)NT + token) * 8 + h];
            const f32x4 g0 = *(const f32x4*)(G + srow * 68 + 8 * lg), g1 = *(const f32x4*)(G + srow * 68 + 8 * lg + 4);
            float o0[8], o1[8], vc[8], vp[8], vn[8], x[8], y[8]; unpack8(wo0, o0); unpack8(wo1, o1); unpack8(wc, vc); unpack8(wp, vp); unpack8(wn, vn);
            float sm = 0.f;
#pragma unroll
            for (int e = 0; e < 8; ++e) { x[e] = o0[e] + o1[e]; sm += x[e]; }
            sm += __shfl_xor(sm, 1); sm += __shfl_xor(sm, 2); sm += __shfl_xor(sm, 4);
            const float mu = sm * (1.f / 64.f); float sq = 0.f;
#pragma unroll
            for (int e = 0; e < 8; ++e) { x[e] -= mu; sq += x[e] * x[e]; }
            sq += __shfl_xor(sq, 1); sq += __shfl_xor(sq, 2); sq += __shfl_xor(sq, 4);
            const float rs = 1.0f / sqrtf(sq * (1.f / 64.f) + GN_EPS_);
#pragma unroll
            for (int e = 0; e < 8; ++e) { const float vs = vc[e] + mvp[e] * (vp[e] - vc[e]) + mvn[e] * (vn[e] - vc[e]); const float gg = e < 4 ? g0[e] : g1[e - 4];
                y[e] = (x[e] * rs * gng[e] + gnb[e] + rk * vs) * gg; }
            *(u32x4*)(Y + token * DM + 64 * h + 8 * lg) = pack8(y); *(u32x4*)(Y + token * DM + 512 + 64 * h + 8 * lg) = yda;
        }
    }
}

#define LP launder_kp(P)
__global__ void __launch_bounds__(512, 2) fwd_megakernel(Params Praw) {
    extern __shared__ __attribute__((aligned(16))) unsigned char shm[];
    cg::grid_group grid = cg::this_grid();
    KP P = (KP)__builtin_amdgcn_kernarg_segment_ptr();
    unsigned char* ws = LP->ws;
    float* X = LP->out; u16* XB = (u16*)(ws + WS_XB); u16* HB = (u16*)(ws + WS_BIG);
    phase0(LP, shm);
    grid.sync();
    for (int l = 0; l < DEPTH_; ++l) {
        { EpiSwiglu E; E.H = HB; run_gemm(shm, XB, (const u16*)(ws + WS_WGU) + (size_t)(l * 2 + 0) * NGU * DM, NGU, DM, E); }
        grid.sync();
        { EpiResid E; E.X = X; E.scale = 0.5f; E.S0 = l == 0 ? LP->in[0] : X; E.S1 = l == 0 ? LP->in[1] : X; E.SB = l == 0 ? nullptr : XB; run_gemm(shm, HB, (const u16*)(ws + WS_WDN) + (size_t)(l * 2 + 0) * DM * DFF, DM, DFF, E); }
        grid.sync();
        ln_phase<0>(X, XB, LP->in[2] + (l * 3 + 0) * DM, LP->in[3] + (l * 3 + 0) * DM);
        grid.sync();
        { EpiProj E; E.PRW = (u16*)(ws + WS_PRW); E.PDA = (u16*)(ws + WS_PDA); E.rt = (const float*)(ws + WS_ROPE); run_gemm(shm, XB, (const u16*)(ws + WS_WIN) + (size_t)l * NINP * DM, NINP, DM, E); }
        grid.sync();
        scan_phase(LP, l, shm);
        attn_phase(LP, l, shm);
        grid.sync();
#ifndef NO_POST
        post_phase(LP, l, shm);
#endif
        grid.sync();
        { EpiResid E; E.X = X; E.scale = 1.0f; E.S0 = X; E.S1 = X; E.SB = nullptr; run_gemm(shm, XB, (const u16*)(ws + WS_WOUT) + (size_t)l * DM * DM, DM, DM, E); }
        grid.sync();
        ln_phase<1>(X, XB, LP->in[2] + (l * 3 + 1) * DM, LP->in[3] + (l * 3 + 1) * DM);
        grid.sync();
        { EpiSwiglu E; E.H = HB; run_gemm(shm, XB, (const u16*)(ws + WS_WGU) + (size_t)(l * 2 + 1) * NGU * DM, NGU, DM, E); }
        grid.sync();
        { EpiResid E; E.X = X; E.scale = 0.5f; E.S0 = X; E.S1 = X; E.SB = XB; run_gemm(shm, HB, (const u16*)(ws + WS_WDN) + (size_t)(l * 2 + 1) * DM * DFF, DM, DFF, E); }
        grid.sync();
        if (l == DEPTH_ - 1) ln_phase<2>(X, XB, LP->in[2] + (l * 3 + 2) * DM, LP->in[3] + (l * 3 + 2) * DM);
        else ln_phase<1>(X, XB, LP->in[2] + (l * 3 + 2) * DM, LP->in[3] + (l * 3 + 2) * DM);
        grid.sync();
    }
}

extern "C" void kernel_launch(void* const* d_in, const int* in_sizes, int n_in, void* d_out, int out_size, void* d_ws, size_t ws_size, hipStream_t stream) {
    static int grid_blocks = 0;
    if (!grid_blocks) {
        int dev = 0, cus = 0, per_cu = 0;
        (void)hipGetDevice(&dev);
        (void)hipDeviceGetAttribute(&cus, hipDeviceAttributeMultiprocessorCount, dev);
        if (hipFuncSetAttribute((const void*)fwd_megakernel, hipFuncAttributeMaxDynamicSharedMemorySize, LDS_BYTES) != hipSuccess) fprintf(stderr, "kernel_launch: hipFuncSetAttribute failed\n");
        (void)hipOccupancyMaxActiveBlocksPerMultiprocessor(&per_cu, (const void*)fwd_megakernel, 512, LDS_BYTES);
        if (per_cu < 1) per_cu = 1;
        grid_blocks = cus * per_cu;
        if (grid_blocks > 256) grid_blocks = 256;
        if (n_in != 21 || ws_size < WS_END) fprintf(stderr, "kernel_launch: unexpected n_in %d / ws_size %zu (need %zu)\n", n_in, ws_size, (size_t)WS_END);
    }
    Params p{};
    for (int i = 0; i < 21; ++i) p.in[i] = (const float*)d_in[i];
    p.out = (float*)d_out; p.ws = (unsigned char*)d_ws;
    for (int i = 0; i < 32; ++i) p.inv[i] = powf(10000.0f, -(float)(2 * i) / 64.0f);
    void* args[] = {&p};
    hipError_t e = hipLaunchCooperativeKernel((const void*)fwd_megakernel, dim3(grid_blocks), dim3(512), args, LDS_BYTES, stream);
    if (e != hipSuccess) fprintf(stderr, "cooperative launch failed: %s (grid %d)\n", hipGetErrorString(e), grid_blocks);
}
#ifdef TESTK
__global__ void __launch_bounds__(512, 2) tk_phase0(Params Praw) { KP P = (KP)__builtin_amdgcn_kernarg_segment_ptr(); extern __shared__ __attribute__((aligned(16))) unsigned char shm[]; phase0(P, shm); }
__global__ void __launch_bounds__(512, 2) tk_gemm_swiglu(Params Praw) { KP P = (KP)__builtin_amdgcn_kernarg_segment_ptr(); extern __shared__ __attribute__((aligned(16))) unsigned char shm[]; EpiSwiglu E; E.H = (u16*)P->ws; run_gemm(shm, (u16*)P->ws, (const u16*)P->ws, NGU, DM, E); }
__global__ void __launch_bounds__(512, 2) tk_gemm_resid(Params Praw) { KP P = (KP)__builtin_amdgcn_kernarg_segment_ptr(); extern __shared__ __attribute__((aligned(16))) unsigned char shm[]; EpiResid E; E.X = P->out; E.scale = 0.5f; run_gemm(shm, (u16*)P->ws, (const u16*)P->ws, DM, DFF, E); }
__global__ void __launch_bounds__(512, 2) tk_gemm_proj(Params Praw) { KP P = (KP)__builtin_amdgcn_kernarg_segment_ptr(); extern __shared__ __attribute__((aligned(16))) unsigned char shm[]; EpiProj E; E.PRW = (u16*)P->ws; E.PDA = (u16*)P->ws; run_gemm(shm, (u16*)P->ws, (const u16*)P->ws, NINP, DM, E); }
__global__ void __launch_bounds__(512, 2) tk_ln(Params Praw) { KP P = (KP)__builtin_amdgcn_kernarg_segment_ptr(); ln_phase<0>(P->out, (u16*)P->ws, P->in[2], P->in[3]); }
__global__ void __launch_bounds__(512, 2) tk_rope(Params Praw) { KP P = (KP)__builtin_amdgcn_kernarg_segment_ptr(); rope_phase((u16*)P->ws, (const float*)P->ws); }
__global__ void __launch_bounds__(512, 2) tk_attn(Params Praw) { KP P = (KP)__builtin_amdgcn_kernarg_segment_ptr(); extern __shared__ __attribute__((aligned(16))) unsigned char shm[]; attn_phase(P, 1, shm); }
__global__ void __launch_bounds__(512, 2) tk_scan(Params Praw) { KP P = (KP)__builtin_amdgcn_kernarg_segment_ptr(); extern __shared__ __attribute__((aligned(16))) unsigned char shm[]; scan_phase(P, 1, shm); }
__global__ void __launch_bounds__(512, 2) tk_post(Params Praw) { KP P = (KP)__builtin_amdgcn_kernarg_segment_ptr(); extern __shared__ __attribute__((aligned(16))) unsigned char shm[]; post_phase(P, 1, shm); }
#endif
#ifdef TESTK
__global__ void __launch_bounds__(512, 2) tk_attn_pass_only(Params Praw) { KP P = (KP)__builtin_amdgcn_kernarg_segment_ptr(); extern __shared__ __attribute__((aligned(16))) unsigned char shm[];
  f32x16 o[4]; float l_reg; const u16* PDA = (const u16*)P->ws;
  att::attn_pass(PDA + blockIdx.x * 1000, PDA + 512, PDA + 1024, (char*)shm, o, l_reg);
  float* out = P->out + threadIdx.x * 65;
  for (int d = 0; d < 4; ++d) for (int r = 0; r < 16; ++r) out[d * 16 + r] = o[d][r] * l_reg;
}
#endif
```

```cpp
#include <hip/hip_runtime.h>
#include <hip/hip_cooperative_groups.h>
#include <cstdio>
#include <cstdint>
#include <cmath>
namespace cg = cooperative_groups;
__device__ __forceinline__ int otid();

namespace pg8 {
#define PG8_LAS __attribute__((address_space(3)))
typedef unsigned short bf16_t;
typedef short bf16x8 __attribute__((ext_vector_type(8)));
typedef float f32x4 __attribute__((ext_vector_type(4)));
typedef unsigned u32x4 __attribute__((ext_vector_type(4)));
constexpr int BM = 256, BK = 64, HALF = 128, HTB = HALF * BK * 2  , STAGE_BYTES = 8 * HTB, NXCD = 8, WGM = 8;

__host__ __device__ __forceinline__ int lds_byte(int r, int c) { const int st = (r >> 4) * 2 + (c >> 5), rr = r & 15, cc = c & 31, ob = rr * 64 + cc * 2; return st * 1024 + (ob ^ (((ob >> 9) & 1) << 5)); }
__host__ __device__ __forceinline__ void stage_rc(int b, int& R, int& C) { const int st = b / 1024, sb = b % 1024, swz = sb ^ (((sb >> 9) & 1) << 5); R = (st >> 1) * 16 + swz / 64; C = (st & 1) * 32 + (swz % 64) / 2; }
__host__ __device__ __forceinline__ int perm32(int rho) { const int n = rho >> 4, i = rho & 15; return 8 * (i >> 2) + 4 * n + (i & 3); }

struct Unit { int pm, pn; };
struct Gemm { const bf16_t* A; const bf16_t* Bt; int M, N, K; };

struct StaticOrder {
    int nM, nN, nwg, G, c;
    __host__ __device__ void init(int M, int N, int G_, int c_) { nM = M / BM; nN = N / BM; nwg = nM * nN; G = G_; c = c_; }
    __host__ __device__ bool next(int i, Unit& u) const {
        const long L = (long)i * G + c; if (L >= nwg) return false;
        int wgid = (int)L; { const int q = nwg / NXCD, r = nwg % NXCD, xcd = wgid % NXCD, off = wgid / NXCD; wgid = (xcd < r ? xcd * (q + 1) : r * (q + 1) + (xcd - r) * q) + off; }
        const int nig = WGM * nN, gid = wgid / nig, fm = gid * WGM, gsz = (nM - fm) < WGM ? (nM - fm) : WGM;
        u.pm = fm + ((wgid % nig) % gsz); u.pn = (wgid % nig) / gsz; return true;
    }
    __device__ __forceinline__ void a_ready(const Unit&) const {}
    __device__ __forceinline__ void done(const Unit&) const {}
};
__device__ __forceinline__ unsigned cvt_pk_bf16(float lo, float hi) { unsigned r; asm volatile("v_cvt_pk_bf16_f32 %0, %1, %2" : "=v"(r) : "v"(lo), "v"(hi)); return r; }

template <class Epi, class Sched, bool ALIGN_EPI = false, bool SP2 = false>
__device__ __forceinline__ void gemm_phase(PG8_LAS unsigned char* lds, const Gemm g, const Sched& S, const Epi& E) {
    const int tid = otid(), wid = __builtin_amdgcn_readfirstlane(tid >> 6), lane = tid & 63, wr = wid >> 2, wc = wid & 3, fr = lane & 15, fq = lane >> 4;
    const int K = g.K, nt = K / BK;
    unsigned voffA[2], voffB[2];
#pragma unroll
    for (int i = 0; i < 2; ++i) { int R, C; stage_rc(tid * 16 + i * 8192, R, C); const int Rb = Epi::PERM ? ((R & ~31) + perm32(R & 31)) : R;
        voffA[i] = (unsigned)(R * K + C) * 2u; voffB[i] = (unsigned)(Rb * K + C) * 2u; }
    const size_t kstep = (size_t)(BK * 2);
    const size_t hstep = (size_t)HALF * K * 2;
    const size_t tstep = 2 * hstep;
    const unsigned ldsw = (unsigned)wid * 1024u;
    const int aoff = lds_byte(wr * 64 + fr, fq * 8), boff = lds_byte(wc * 32 + fr, fq * 8);
#define PG8_SA(b, h) (((b) * 2 + (h)) * HTB)
#define PG8_SB(b, h) ((4 + (b) * 2 + (h)) * HTB)
#define PG8_STAGE(bufoff, gbase, voff) do { _Pragma("unroll") for (int _i = 0; _i < 2; ++_i) \
        __builtin_amdgcn_global_load_lds((const unsigned*)((const char*)(gbase) + (voff)[_i]), (PG8_LAS unsigned*)(lds + (bufoff) + ldsw + _i * 8192), 16, 0, 0); } while (0)
#define PG8_LDA(dst, b, h) do { _Pragma("unroll") for (int m = 0; m < 4; ++m) _Pragma("unroll") for (int k = 0; k < 2; ++k) dst[m][k] = *(const PG8_LAS bf16x8*)(lds + PG8_SA(b, h) + aoff + m * 2048 + k * 1024); } while (0)
#define PG8_LDB(dst, b, h) do { _Pragma("unroll") for (int n = 0; n < 2; ++n) _Pragma("unroll") for (int k = 0; k < 2; ++k) dst[n][k] = *(const PG8_LAS bf16x8*)(lds + PG8_SB(b, h) + boff + n * 2048 + k * 1024); } while (0)
#define PG8_MMA(ai, bj, At, Bt) do { __builtin_amdgcn_s_setprio(1); _Pragma("unroll") for (int m = 0; m < 4; ++m) _Pragma("unroll") for (int n = 0; n < 2; ++n) _Pragma("unroll") for (int k = 0; k < 2; ++k) \
        acc[ai][bj][m][n] = __builtin_amdgcn_mfma_f32_16x16x32_bf16(Bt[n][k], At[m][k], acc[ai][bj][m][n], 0, 0, 0); __builtin_amdgcn_s_setprio(0); } while (0)
#define PG8_WAIT_V(n) asm volatile("s_waitcnt vmcnt(" #n ")" ::: "memory")
#define PG8_WAIT_L(n) asm volatile("s_waitcnt lgkmcnt(" #n ")" ::: "memory")
#define PG8_BAR __builtin_amdgcn_s_barrier()
#define PG8_SCHED __builtin_amdgcn_sched_barrier(0)
    Unit cur, nxt; int ui = 0;
    if (!S.next(0, cur)) return;
    f32x4 acc[2][2][4][2];
#pragma unroll
    for (int a = 0; a < 2; ++a)
#pragma unroll
        for (int b = 0; b < 2; ++b)
#pragma unroll
            for (int m = 0; m < 4; ++m)
#pragma unroll
                for (int n = 0; n < 2; ++n) acc[a][b][m][n] = (f32x4){0.f, 0.f, 0.f, 0.f};
    bf16x8 At[4][2], B0[2][2], B1[2][2];
    const char* cA = (const char*)g.A + (size_t)cur.pm * tstep; const char* cB = (const char*)g.Bt + (size_t)cur.pn * tstep;
    S.a_ready(cur);
    if constexpr (SP2) {
        PG8_STAGE(PG8_SB(0, 0), cB, voffB); PG8_STAGE(PG8_SB(0, 1), cB + hstep, voffB); PG8_STAGE(PG8_SA(0, 0), cA, voffA); PG8_STAGE(PG8_SA(0, 1), cA + hstep, voffA);
        if (wr == 1) PG8_BAR;
        PG8_WAIT_V(2); PG8_BAR;
        PG8_STAGE(PG8_SB(1, 0), cB + kstep, voffB); PG8_STAGE(PG8_SA(1, 0), cA + kstep, voffA); PG8_STAGE(PG8_SB(1, 1), cB + hstep + kstep, voffB);
        PG8_WAIT_V(6); PG8_BAR;
    } else {
        PG8_STAGE(PG8_SB(0, 0), cB, voffB); PG8_STAGE(PG8_SA(0, 0), cA, voffA); PG8_STAGE(PG8_SB(0, 1), cB + hstep, voffB); PG8_STAGE(PG8_SA(0, 1), cA + hstep, voffA);
        if (wr == 1) PG8_BAR;
        PG8_WAIT_V(4); PG8_BAR;
        PG8_STAGE(PG8_SB(1, 0), cB + kstep, voffB); PG8_STAGE(PG8_SA(1, 0), cA + kstep, voffA); PG8_STAGE(PG8_SB(1, 1), cB + hstep + kstep, voffB);
        PG8_WAIT_V(6); PG8_BAR;
    }
    for (;;) {
        const bool has_next = S.next(ui + 1, nxt);
        const char* nA = has_next ? (const char*)g.A + (size_t)nxt.pm * tstep : cA; const char* nB = has_next ? (const char*)g.Bt + (size_t)nxt.pn * tstep : cB;
        for (int t = 0; t < nt; t += 2) {
            const bool last = (t == nt - 2);
            const char* a1 = cA + (size_t)(t + 1) * kstep;
            const char* a2 = last ? nA : cA + (size_t)(t + 2) * kstep; const char* b2 = last ? nB : cB + (size_t)(t + 2) * kstep;
            const char* a3 = a2 + kstep; const char* b3 = b2 + kstep;
            if (last && has_next) S.a_ready(nxt);
            if constexpr (SP2) {
            PG8_LDB(B0, 0, 0); PG8_LDB(B1, 0, 1); PG8_SCHED; PG8_LDA(At, 0, 0); PG8_STAGE(PG8_SA(1, 1), a1 + hstep, voffA);
            PG8_WAIT_V(8); PG8_WAIT_L(0); PG8_BAR; PG8_MMA(0, 0, At, B0); PG8_MMA(0, 1, At, B1); PG8_BAR; PG8_SCHED;
            PG8_LDA(At, 0, 1); PG8_STAGE(PG8_SB(0, 0), b2, voffB); PG8_STAGE(PG8_SB(0, 1), b2 + hstep, voffB); PG8_STAGE(PG8_SA(0, 0), a2, voffA);
            PG8_WAIT_V(8); PG8_WAIT_L(0); PG8_BAR; PG8_MMA(1, 0, At, B0); PG8_MMA(1, 1, At, B1); PG8_BAR; PG8_SCHED;
            PG8_LDB(B0, 1, 0); PG8_LDB(B1, 1, 1); PG8_SCHED; PG8_LDA(At, 1, 0); PG8_STAGE(PG8_SA(0, 1), a2 + hstep, voffA);
            PG8_WAIT_V(8); PG8_WAIT_L(0); PG8_BAR; PG8_MMA(0, 0, At, B0); PG8_MMA(0, 1, At, B1); PG8_BAR; PG8_SCHED;
            PG8_LDA(At, 1, 1); PG8_STAGE(PG8_SB(1, 0), b3, voffB); PG8_STAGE(PG8_SB(1, 1), b3 + hstep, voffB); PG8_STAGE(PG8_SA(1, 0), a3, voffA);
            PG8_WAIT_V(8); PG8_WAIT_L(0); PG8_BAR; PG8_MMA(1, 0, At, B0); PG8_MMA(1, 1, At, B1); PG8_BAR; PG8_SCHED;
            } else {
            PG8_LDB(B0, 0, 0); PG8_SCHED; PG8_LDA(At, 0, 0); PG8_STAGE(PG8_SA(1, 1), a1 + hstep, voffA);
            PG8_WAIT_L(8); PG8_BAR; PG8_WAIT_L(0); PG8_MMA(0, 0, At, B0); PG8_BAR; PG8_SCHED;
            PG8_LDB(B1, 0, 1); PG8_STAGE(PG8_SB(0, 0), b2, voffB);
            PG8_BAR; PG8_WAIT_L(0); PG8_MMA(0, 1, At, B1); PG8_BAR;
            PG8_LDA(At, 0, 1); PG8_STAGE(PG8_SA(0, 0), a2, voffA);
            PG8_BAR; PG8_WAIT_L(0); PG8_MMA(1, 0, At, B0); PG8_BAR; PG8_SCHED;
            PG8_STAGE(PG8_SB(0, 1), b2 + hstep, voffB);
            PG8_WAIT_V(6); PG8_BAR; PG8_MMA(1, 1, At, B1); PG8_BAR;
            PG8_LDB(B0, 1, 0); PG8_SCHED; PG8_LDA(At, 1, 0); PG8_STAGE(PG8_SA(0, 1), a2 + hstep, voffA);
            PG8_WAIT_L(8); PG8_BAR; PG8_WAIT_L(0); PG8_MMA(0, 0, At, B0); PG8_BAR; PG8_SCHED;
            PG8_LDB(B1, 1, 1); PG8_STAGE(PG8_SB(1, 0), b3, voffB);
            PG8_BAR; PG8_WAIT_L(0); PG8_MMA(0, 1, At, B1); PG8_BAR;
            PG8_LDA(At, 1, 1); PG8_STAGE(PG8_SA(1, 0), a3, voffA);
            PG8_BAR; PG8_WAIT_L(0); PG8_MMA(1, 0, At, B0); PG8_BAR; PG8_SCHED;
            PG8_STAGE(PG8_SB(1, 1), b3 + hstep, voffB);
            PG8_WAIT_V(6); PG8_BAR; PG8_MMA(1, 1, At, B1); PG8_BAR;
            }
        }
        if constexpr (ALIGN_EPI) { if (wr == 0) PG8_BAR; }
        if constexpr (!Epi::AFTER_DRAIN) { E(acc, cur, wr, wc, fr, fq); S.done(cur); }
        if (!has_next) break;
#pragma unroll
        for (int a = 0; a < 2; ++a)
#pragma unroll
            for (int b = 0; b < 2; ++b)
#pragma unroll
                for (int m = 0; m < 4; ++m)
#pragma unroll
                    for (int n = 0; n < 2; ++n) acc[a][b][m][n] = (f32x4){0.f, 0.f, 0.f, 0.f};
        cur = nxt; cA = nA; cB = nB; ++ui;
        if constexpr (ALIGN_EPI) { if (wr == 1) PG8_BAR; }
    }
    PG8_WAIT_V(0);
    if constexpr (!ALIGN_EPI) { if (wr == 0) PG8_BAR; }
    PG8_BAR;
    if constexpr (Epi::AFTER_DRAIN) { E.fused(acc, cur, wr, wc, fr, fq, lds, wid, lane); S.done(cur); }
#undef PG8_SA
#undef PG8_SB
#undef PG8_STAGE
#undef PG8_LDA
#undef PG8_LDB
#undef PG8_MMA
#undef PG8_WAIT_V
#undef PG8_WAIT_L
#undef PG8_BAR
#undef PG8_SCHED
}
}

typedef unsigned short u16;
using pg8::bf16x8; using pg8::f32x4; using pg8::u32x4;
typedef short s16x4 __attribute__((ext_vector_type(4)));
typedef float f32x16 __attribute__((ext_vector_type(16)));
typedef unsigned u32x2 __attribute__((ext_vector_type(2)));

constexpr int DM = 1024, TSEQ = 8192, NSEQ = 12, NT = NSEQ * TSEQ, DEPTH_ = 2;
constexpr int DFF = 2816, NGU = 2 * DFF, NIN = 3456, NINP = 3584, RWC = 1920, DAC = 1536;
constexpr float ALPHA_ = 1.4142135623730951f;
constexpr float LN_EPS_ = 1e-5f, GN_EPS_ = 64e-5f, SUBLN_EPS_ = 1e-5f;
constexpr int LDS_BYTES = 163840;

constexpr size_t WS_WGU = 0;
constexpr size_t WS_WDN = WS_WGU + (size_t)2 * 2 * NGU * DM * 2;
constexpr size_t WS_WIN = WS_WDN + (size_t)2 * 2 * DM * DFF * 2;
constexpr size_t WS_WOUT = WS_WIN + (size_t)2 * NINP * DM * 2;
constexpr size_t WS_WUP = WS_WOUT + (size_t)2 * DM * DM * 2;
constexpr size_t WS_AUP = WS_WUP + (size_t)2 * 2 * 512 * 64 * 2;
constexpr size_t WS_GUP = WS_AUP + (size_t)2 * 2 * 512 * 64 * 2;
constexpr size_t WS_ROPE = WS_GUP + (size_t)2 * 512 * 128 * 2;
constexpr size_t WS_RK = WS_ROPE + (size_t)TSEQ * 32 * 2 * 4;
constexpr size_t WS_SCR = WS_RK + (size_t)2 * NT * 8 * 4;
constexpr size_t WS_Q = WS_SCR + (size_t)256 * 256 * 128 * 4;
constexpr size_t WS_XB = WS_Q + (size_t)4096;
constexpr size_t WS_BIG = WS_XB + (size_t)NT * DM * 2;
constexpr size_t WS_PRW = WS_BIG;
constexpr size_t WS_PDA = WS_PRW + (size_t)NT * RWC * 2;
constexpr size_t WS_END = WS_PDA + (size_t)NT * DAC * 2;
static_assert(WS_BIG + (size_t)NT * DFF * 2 <= WS_END, "H fits");
static_assert(WS_END <= (size_t)1073741824, "workspace budget");

struct Params {
    const float* in[21];
    float* out;
    unsigned char* ws;
    float inv[32];
};

typedef const __attribute__((address_space(4))) Params* KP;
__device__ __forceinline__ KP launder_kp(KP p) { asm volatile("" : "+s"(p)); return p; }
__device__ __forceinline__ int otid() { int t = threadIdx.x; asm volatile("" : "+v"(t)); return t; }
__device__ __forceinline__ float bf2f(u16 b) { return __uint_as_float(((unsigned)b) << 16); }
__device__ __forceinline__ float bflo(unsigned w) { return __uint_as_float(w << 16); }
__device__ __forceinline__ float bfhi(unsigned w) { return __uint_as_float(w & 0xffff0000u); }
__device__ __forceinline__ unsigned cvtpk(float lo, float hi) { return pg8::cvt_pk_bf16(lo, hi); }
__device__ __forceinline__ u16 f2bf(float x) { return (u16)(cvtpk(x, 0.f) & 0xffffu); }
__device__ __forceinline__ void unpack8(const u32x4 w, float* f) {
    f[0] = bflo(w[0]); f[1] = bfhi(w[0]); f[2] = bflo(w[1]); f[3] = bfhi(w[1]); f[4] = bflo(w[2]); f[5] = bfhi(w[2]); f[6] = bflo(w[3]); f[7] = bfhi(w[3]);
}
__device__ __forceinline__ u32x4 pack8(const float* f) { u32x4 w = {cvtpk(f[0], f[1]), cvtpk(f[2], f[3]), cvtpk(f[4], f[5]), cvtpk(f[6], f[7])}; return w; }
__device__ __forceinline__ int crow(int r, int hi) { return (r & 3) + 8 * (r >> 2) + 4 * hi; }
__device__ __forceinline__ float sigmoidf_(float x) { return 1.f / (1.f + __expf(-x)); }

struct EpiSwiglu {
    static constexpr bool PERM = true, AFTER_DRAIN = false;
    u16* H;
    __device__ __forceinline__ void operator()(const f32x4 (&acc)[2][2][4][2], const pg8::Unit& u, int wr, int wc, int fr, int fq) const {
        const int row0 = u.pm * 256 + wr * 64 + fr, col0 = u.pn * 128 + wc * 32 + 8 * fq;
#pragma unroll
        for (int ai = 0; ai < 2; ++ai)
#pragma unroll
            for (int m = 0; m < 4; ++m) {
                float o[8];
#pragma unroll
                for (int n = 0; n < 2; ++n)
#pragma unroll
                    for (int e = 0; e < 4; ++e) { const float g = acc[ai][0][m][n][e], up = acc[ai][1][m][n][e]; o[n * 4 + e] = g * __builtin_amdgcn_rcpf(1.f + __builtin_amdgcn_exp2f(g * -1.4426950408889634f)) * up; }
                *(u32x4*)(H + (size_t)(row0 + ai * 128 + m * 16) * DFF + col0) = pack8(o);
            }
    }
};
struct EpiResid {
    static constexpr bool PERM = false, AFTER_DRAIN = false;
    float* X; float scale; const float* S0; const float* S1; const u16* SB;
    __device__ __forceinline__ void operator()(const f32x4 (&acc)[2][2][4][2], const pg8::Unit& u, int wr, int wc, int fr, int fq) const {
        const int row0 = u.pm * 256 + wr * 64 + fr, col0 = u.pn * 256 + wc * 32 + 4 * fq;
        const float* src = u.pm < 256 ? S0 : S1 - (size_t)65536 * DM * (S1 != X);
#pragma unroll
        for (int ai = 0; ai < 2; ++ai)
#pragma unroll
            for (int m = 0; m < 4; ++m) { const size_t ro = (size_t)(row0 + ai * 128 + m * 16) * DM + col0;
#pragma unroll
                for (int bj = 0; bj < 2; ++bj)
#pragma unroll
                    for (int n = 0; n < 2; ++n) { f32x4 x;
                        if (SB) { const u32x2 w = *(const u32x2*)(SB + ro + bj * 128 + n * 16); x = (f32x4){bflo(w[0]), bfhi(w[0]), bflo(w[1]), bfhi(w[1])}; }
                        else x = *(const f32x4*)(src + ro + bj * 128 + n * 16);
                        *(f32x4*)(X + ro + bj * 128 + n * 16) = x * ALPHA_ + acc[ai][bj][m][n] * scale; } }
    }
};
struct EpiProj {
    static constexpr bool PERM = true, AFTER_DRAIN = false;
    u16* PRW; u16* PDA; const float* rt;
    __device__ __forceinline__ void operator()(const f32x4 (&acc)[2][2][4][2], const pg8::Unit& u, int wr, int wc, int fr, int fq) const {
        const int row0 = u.pm * 256 + wr * 64 + fr;
#pragma unroll
        for (int bj = 0; bj < 2; ++bj) {
            const int cb = u.pn * 256 + bj * 128;
            if (cb >= RWC && cb < RWC + 1024) {
                const int i4 = 4 * (4 * (wc & 1) + fq);
                u16* vb = PDA + (cb - RWC) + 64 * (wc >> 1) + i4;
#pragma unroll
                for (int ai = 0; ai < 2; ++ai)
#pragma unroll
                    for (int m = 0; m < 4; ++m) {
                        const int row = row0 + ai * 128 + m * 16, pos = row & (TSEQ - 1);
                        const f32x4 t0 = *(const f32x4*)(rt + (pos * 32 + i4) * 2), t1 = *(const f32x4*)(rt + (pos * 32 + i4) * 2 + 4);
                        const f32x4 x1 = acc[ai][bj][m][0], x2 = acc[ai][bj][m][1];
                        const f32x4 cs = {t0[0], t0[2], t1[0], t1[2]}, sn = {t0[1], t0[3], t1[1], t1[3]};
                        const f32x4 o1 = x1 * cs - x2 * sn, o2 = x2 * cs + x1 * sn;
                        u32x2 w1 = {cvtpk(o1[0], o1[1]), cvtpk(o1[2], o1[3])}, w2 = {cvtpk(o2[0], o2[1]), cvtpk(o2[2], o2[3])};
                        *(u32x2*)(vb + (size_t)row * DAC) = w1; *(u32x2*)(vb + (size_t)row * DAC + 32) = w2;
                    }
                continue;
            }
            u16* base; int ld;
            if (cb < RWC) { base = PRW + cb; ld = RWC; } else if (cb < NIN) { base = PDA + (cb - RWC); ld = DAC; } else continue;
            base += wc * 32 + 8 * fq;
#pragma unroll
            for (int ai = 0; ai < 2; ++ai)
#pragma unroll
                for (int m = 0; m < 4; ++m) {
                    float o[8];
#pragma unroll
                    for (int n = 0; n < 2; ++n)
#pragma unroll
                        for (int e = 0; e < 4; ++e) o[n * 4 + e] = acc[ai][bj][m][n][e];
                    *(u32x4*)(base + (size_t)(row0 + ai * 128 + m * 16) * ld) = pack8(o);
                }
        }
    }
};

template <class Epi>
__device__ __forceinline__ void run_gemm(unsigned char* shm, const u16* A, const u16* Bt, int N, int K, const Epi& E) {
    pg8::Gemm g; g.A = A; g.Bt = Bt; g.M = NT; g.N = N; g.K = K;
    pg8::StaticOrder S; S.init(NT, N, (int)gridDim.x, (int)blockIdx.x);
    pg8::gemm_phase<Epi, pg8::StaticOrder, true, true>((PG8_LAS unsigned char*)shm, g, S, E);
}

template <int MAP>
__device__ __forceinline__ void tr_job(const float* __restrict__ src, int K, int ld, u16* __restrict__ dst, int Ndst, float* tile) {
    const int tid = otid(), ntk = K / 64, ntn = Ndst / 64;
    for (int ti = blockIdx.x; ti < ntk * ntn; ti += gridDim.x) {
        const int tn = ti / ntk, tk = ti % ntk, n0 = tn * 64, k0 = tk * 64;
        int sc0 = n0; bool zero = false;
        if (MAP == 1) { const int pn = n0 >> 8, bj = (n0 >> 7) & 1, c = n0 & 127; sc0 = bj * DFF + pn * 128 + c; }
        if (MAP == 2) zero = n0 >= NIN;
        const int c4 = (tid & 15) * 4;
#pragma unroll
        for (int p = 0; p < 2; ++p) { const int kr = (tid >> 4) + p * 32;
            f32x4 v = {0.f, 0.f, 0.f, 0.f}; if (!zero) v = *(const f32x4*)(src + (size_t)(k0 + kr) * ld + sc0 + c4);
            tile[kr * 65 + c4 + 0] = v[0]; tile[kr * 65 + c4 + 1] = v[1]; tile[kr * 65 + c4 + 2] = v[2]; tile[kr * 65 + c4 + 3] = v[3]; }
        __syncthreads();
        { const int nr = tid >> 3, kc = (tid & 7) * 8; float f[8];
          const int nrs = (MAP == 2 && n0 >= RWC && n0 < RWC + 1024) ? (((nr & 7) < 4) ? 4 * (nr >> 3) + (nr & 7) : 32 + 4 * (nr >> 3) + (nr & 7) - 4) : nr;
#pragma unroll
          for (int e = 0; e < 8; ++e) f[e] = tile[(kc + e) * 65 + nrs];
          *(u32x4*)(dst + (size_t)(n0 + nr) * K + k0 + kc) = pack8(f); }
        __syncthreads();
    }
}

__device__ __forceinline__ void phase0(KP P, unsigned char* shm) {
    float* tile = (float*)shm; unsigned char* ws = P->ws;
    for (int i = 0; i < 4; ++i) {
        tr_job<1>(P->in[4] + (size_t)i * DM * NGU, DM, NGU, (u16*)(ws + WS_WGU) + (size_t)i * NGU * DM, NGU, tile);
        tr_job<0>(P->in[5] + (size_t)i * DFF * DM, DFF, DM, (u16*)(ws + WS_WDN) + (size_t)i * DM * DFF, DM, tile);
        tr_job<0>(P->in[9] + (size_t)i * 64 * 512, 64, 512, (u16*)(ws + WS_WUP) + (size_t)i * 512 * 64, 512, tile);
        tr_job<0>(P->in[11] + (size_t)i * 64 * 512, 64, 512, (u16*)(ws + WS_AUP) + (size_t)i * 512 * 64, 512, tile);
    }
    for (int l = 0; l < 2; ++l) {
        tr_job<2>(P->in[6] + (size_t)l * DM * NIN, DM, NIN, (u16*)(ws + WS_WIN) + (size_t)l * NINP * DM, NINP, tile);
        tr_job<0>(P->in[7] + (size_t)l * DM * DM, DM, DM, (u16*)(ws + WS_WOUT) + (size_t)l * DM * DM, DM, tile);
        tr_job<0>(P->in[13] + (size_t)l * 128 * 512, 128, 512, (u16*)(ws + WS_GUP) + (size_t)l * 512 * 128, 512, tile);
    }
    const size_t gt = (size_t)blockIdx.x * 512 + otid(), gn = (size_t)gridDim.x * 512;
    { unsigned* qz = (unsigned*)(ws + WS_Q); for (size_t i = gt; i < 1024; i += gn) qz[i] = 0u; }
    { const size_t n4 = (size_t)NT * DM / 4, np4 = (size_t)8 * TSEQ * DM / 4;
      const f32x4* xp = (const f32x4*)P->in[0]; const f32x4* xs = (const f32x4*)P->in[1]; u32x2* xb = (u32x2*)(ws + WS_XB);
      for (size_t i = gt; i < n4; i += gn) { const f32x4 v = i < np4 ? xp[i] : xs[i - np4]; u32x2 w = {cvtpk(v[0], v[1]), cvtpk(v[2], v[3])}; xb[i] = w; } }
    { float* rt = (float*)(ws + WS_ROPE);
      for (size_t idx = gt; idx < (size_t)TSEQ * 32; idx += gn) {
          const int t = (int)(idx >> 5), i = (int)(idx & 31);
          const float angf = (float)t * P->inv[i];
          const double x = (double)angf, n = rint(x * 0.63661977236758134308), r = fma(-n, 6.123233995736766e-17, fma(-n, 1.5707963267948966, x));
          const int q = ((int)n) & 3; const double r2 = r * r;
          double sn = r2 * (1.0 / 6227020800.0) - (1.0 / 39916800.0); sn = sn * r2 + (1.0 / 362880.0); sn = sn * r2 - (1.0 / 5040.0); sn = sn * r2 + (1.0 / 120.0); sn = sn * r2 - (1.0 / 6.0); sn = sn * r2 * r + r;
          double cs = r2 * (-1.0 / 87178291200.0) + (1.0 / 479001600.0); cs = cs * r2 - (1.0 / 3628800.0); cs = cs * r2 + (1.0 / 40320.0); cs = cs * r2 - (1.0 / 720.0); cs = cs * r2 + (1.0 / 24.0); cs = cs * r2 - 0.5; cs = cs * r2 + 1.0;
          double s_, c_; if (q == 0) { s_ = sn; c_ = cs; } else if (q == 1) { s_ = cs; c_ = -sn; } else if (q == 2) { s_ = -sn; c_ = -cs; } else { s_ = -cs; c_ = sn; }
          rt[idx * 2 + 0] = (float)c_; rt[idx * 2 + 1] = (float)s_;
      } }
}

__device__ __forceinline__ float wave_sum(float x) {
#pragma unroll
    for (int o = 32; o >= 1; o >>= 1) x += __shfl_xor(x, o);
    return x;
}
template <int MODE>
__device__ __forceinline__ void ln_phase(float* X, u16* Xb, const float* __restrict__ g, const float* __restrict__ b) {
    const int tid_ = otid(), wid = tid_ >> 6, lane = tid_ & 63;
    f32x4 gv[4], bv[4];
#pragma unroll
    for (int j = 0; j < 4; ++j) { gv[j] = *(const f32x4*)(g + j * 256 + lane * 4); bv[j] = *(const f32x4*)(b + j * 256 + lane * 4); }
    for (int row = blockIdx.x * 8 + wid; row < NT; row += gridDim.x * 8) {
        float* xr = X + (size_t)row * DM; f32x4 v[4]; float s = 0.f;
#pragma unroll
        for (int j = 0; j < 4; ++j) { v[j] = *(const f32x4*)(xr + j * 256 + lane * 4); s += v[j][0] + v[j][1] + v[j][2] + v[j][3]; }
        const float mu = wave_sum(s) * (1.f / DM); float q = 0.f;
#pragma unroll
        for (int j = 0; j < 4; ++j) { v[j] = v[j] - mu; q += v[j][0] * v[j][0] + v[j][1] * v[j][1] + v[j][2] * v[j][2] + v[j][3] * v[j][3]; }
        const float rs = 1.0f / sqrtf(wave_sum(q) * (1.f / DM) + LN_EPS_);
#pragma unroll
        for (int j = 0; j < 4; ++j) { const f32x4 y = v[j] * rs * gv[j] + bv[j];
            if (MODE != 1) *(f32x4*)(xr + j * 256 + lane * 4) = y;
            if (MODE != 2) { u32x2 w = {cvtpk(y[0], y[1]), cvtpk(y[2], y[3])}; *(u32x2*)(Xb + (size_t)row * DM + j * 256 + lane * 4) = w; } }
    }
}

__device__ __forceinline__ void rope_phase(u16* PDA, const float* __restrict__ rt) {
    const size_t total = (size_t)NT * 64;
    for (size_t i = (size_t)blockIdx.x * 512 + otid(); i < total; i += (size_t)gridDim.x * 512) {
        const int token = (int)(i >> 6), sub = (int)(i & 63), vec = sub >> 2, f0 = (sub & 3) * 8, pos = token & (TSEQ - 1);
        u16* p = PDA + (size_t)token * DAC + vec * 64 + f0;
        const u32x4 w1 = *(const u32x4*)p, w2 = *(const u32x4*)(p + 32);
        float x1[8], x2[8], o1[8], o2[8]; unpack8(w1, x1); unpack8(w2, x2);
        const float* cs = rt + ((size_t)pos * 32 + f0) * 2;
#pragma unroll
        for (int e = 0; e < 8; ++e) { const float c = cs[2 * e], s = cs[2 * e + 1]; o1[e] = x1[e] * c - x2[e] * s; o2[e] = x2[e] * c + x1[e] * s; }
        *(u32x4*)p = pack8(o1); *(u32x4*)(p + 32) = pack8(o2);
    }
}

namespace att {
constexpr int NW = 8, QBLK = 32, KVBLK = 64, LDQ = DAC;
constexpr float SCALE = 0.125f, THR = 8.f;
constexpr int SHM_V = KVBLK * 128 * 2, SHM_K = KVBLK * 64 * 2;
#define KSWZ(row, colB) ((row) * 128 + ((colB) ^ ((((row) >> 1) & 7) << 4)))
#define SBAR() __builtin_amdgcn_sched_barrier(0)
__device__ __forceinline__ void partialSM(f32x16& p0, f32x16& p1, float& m_reg, float& mn, float& alpha) {
    constexpr float C = SCALE * 1.4426950408889634f;
    float pmax = p0[0];
#pragma unroll
    for (int r = 1; r < 16; ++r) pmax = fmaxf(pmax, p0[r]);
#pragma unroll
    for (int r = 0; r < 16; ++r) pmax = fmaxf(pmax, p1[r]);
    { auto rr = __builtin_amdgcn_permlane32_swap(__float_as_uint(pmax), __float_as_uint(pmax), false, false);
      pmax = fmaxf(__uint_as_float(rr[0]), __uint_as_float(rr[1])); }
    if (__builtin_expect(__all(pmax - m_reg <= THR / SCALE), 1)) { mn = m_reg; alpha = 1.f; }
    else { mn = fmaxf(m_reg, pmax); alpha = __builtin_amdgcn_exp2f((m_reg - mn) * C); m_reg = mn; }
    const float mnC = -mn * C;
#pragma unroll
    for (int r = 0; r < 16; ++r) p0[r] = fmaf(p0[r], C, mnC);
#pragma unroll
    for (int r = 0; r < 16; ++r) p1[r] = fmaf(p1[r], C, mnC);
#pragma unroll
    for (int r = 0; r < 16; ++r) p0[r] = __builtin_amdgcn_exp2f(p0[r]);
}
__device__ __forceinline__ void finishSM(f32x16& p0, f32x16& p1, float alpha, float& l_reg, bf16x8& pa0, bf16x8& pa1, bf16x8& pa2, bf16x8& pa3) {
#pragma unroll
    for (int r = 0; r < 16; ++r) p1[r] = __builtin_amdgcn_exp2f(p1[r]);
    float ps = 0;
#pragma unroll
    for (int r = 0; r < 16; ++r) ps += p0[r];
#pragma unroll
    for (int r = 0; r < 16; ++r) ps += p1[r];
    { auto rr = __builtin_amdgcn_permlane32_swap(__float_as_uint(ps), __float_as_uint(ps), false, false);
      ps = __uint_as_float(rr[0]) + __uint_as_float(rr[1]); }
    l_reg = l_reg * alpha + ps;
#define PK4(P, BASE, OUT) do { unsigned a0 = cvtpk(P[BASE + 0], P[BASE + 1]), a1 = cvtpk(P[BASE + 2], P[BASE + 3]);   \
    unsigned b0 = cvtpk(P[BASE + 4], P[BASE + 5]), b1 = cvtpk(P[BASE + 6], P[BASE + 7]);                              \
    auto r0 = __builtin_amdgcn_permlane32_swap(a0, b0, false, false); auto r1 = __builtin_amdgcn_permlane32_swap(a1, b1, false, false); \
    u32x4 w = {r0[0], r1[0], r0[1], r1[1]}; OUT = *reinterpret_cast<bf16x8*>(&w); } while (0)
    PK4(p0, 0, pa0); PK4(p0, 8, pa1); PK4(p1, 0, pa2); PK4(p1, 8, pa3);
#undef PK4
}
__device__ __forceinline__ void qkt(f32x16& p0, f32x16& p1, const char* Ks, const bf16x8* qr, int r32, int hi) {
    p0 = f32x16{}; p1 = f32x16{};
#pragma unroll
    for (int d0 = 0; d0 < 4; ++d0) { const int cb = (d0 * 16 + hi * 8) * 2;
        const bf16x8 b0 = *reinterpret_cast<const bf16x8*>(Ks + KSWZ(r32, cb));
        const bf16x8 b1 = *reinterpret_cast<const bf16x8*>(Ks + KSWZ(32 + r32, cb));
        p0 = __builtin_amdgcn_mfma_f32_32x32x16_bf16(b0, qr[d0], p0, 0, 0, 0);
        p1 = __builtin_amdgcn_mfma_f32_32x32x16_bf16(b1, qr[d0], p1, 0, 0, 0); }
}
__device__ __forceinline__ int v_st(int k, int c) { const int kk = (k & ~0xC) | ((k & 4) << 1) | ((k & 8) >> 1); return ((kk >> 3) * 4 + (c >> 5)) * 512 + ((kk & 7) * 32 + (c & 31)) * 2; }
__device__ __forceinline__ int v_rd_base(int lane) { return ((lane & 3) << 3) | (((lane >> 2) & 3) << 6) | (((lane >> 4) & 1) << 5) | (((lane >> 5) & 1) << 8); }
constexpr int v_rd_off(int d0, int ks, int half) { return d0 * 512 + ks * 4096 + half * 2048; }
template <int OFF> __device__ __forceinline__ s16x4 tr_read(int vb) {
    s16x4 r; asm volatile("ds_read_b64_tr_b16 %0, %1 offset:%2" : "=&v"(r) : "v"(vb), "i"(OFF) : "memory"); return r;
}
template <int D0> __device__ __forceinline__ void pv_one(f32x16& od, int vb, bf16x8 pa0, bf16x8 pa1, bf16x8 pa2, bf16x8 pa3) {
    const s16x4 l0 = tr_read<v_rd_off(D0, 0, 0)>(vb), h0 = tr_read<v_rd_off(D0, 0, 1)>(vb), l1 = tr_read<v_rd_off(D0, 1, 0)>(vb), h1 = tr_read<v_rd_off(D0, 1, 1)>(vb);
    const s16x4 l2 = tr_read<v_rd_off(D0, 2, 0)>(vb), h2 = tr_read<v_rd_off(D0, 2, 1)>(vb), l3 = tr_read<v_rd_off(D0, 3, 0)>(vb), h3 = tr_read<v_rd_off(D0, 3, 1)>(vb);
    asm volatile("s_waitcnt lgkmcnt(0)" ::: "memory"); SBAR();
#define PK(L, H) (bf16x8){L[0], L[1], L[2], L[3], H[0], H[1], H[2], H[3]}
    od = __builtin_amdgcn_mfma_f32_32x32x16_bf16(pa0, PK(l0, h0), od, 0, 0, 0);
    od = __builtin_amdgcn_mfma_f32_32x32x16_bf16(pa1, PK(l1, h1), od, 0, 0, 0);
    od = __builtin_amdgcn_mfma_f32_32x32x16_bf16(pa2, PK(l2, h2), od, 0, 0, 0);
    od = __builtin_amdgcn_mfma_f32_32x32x16_bf16(pa3, PK(l3, h3), od, 0, 0, 0);
#undef PK
}
__device__ __forceinline__ void pv_d0(f32x16* o, int vb, bf16x8 pa0, bf16x8 pa1, bf16x8 pa2, bf16x8 pa3) {
    pv_one<0>(o[0], vb, pa0, pa1, pa2, pa3); pv_one<1>(o[1], vb, pa0, pa1, pa2, pa3); pv_one<2>(o[2], vb, pa0, pa1, pa2, pa3); pv_one<3>(o[3], vb, pa0, pa1, pa2, pa3);
}

__device__ __forceinline__ void attn_pass(const u16* __restrict__ Qb, const u16* __restrict__ Kh, const u16* __restrict__ Vh, char* lds, f32x16* o, float& l_out) {
    const int tid = otid(), wid = tid >> 6, lane = tid & 63, r32 = lane & 31, hi = lane >> 5, cp = wid >> 2, wq = wid & 3;
    char* V_lds = lds; char* K_lds = lds + 2 * SHM_V;
    float* wsl = (float*)(lds + 2 * SHM_V + 4 * SHM_K) + wid * 64; float* al_l = wsl + 32;
    float m_reg = -1e30f, l_reg = 0;
#pragma unroll
    for (int d = 0; d < 4; ++d) o[d] = f32x16{};
    bf16x8 qr[4];
    const u16* Qw = Qb + (size_t)(wq * QBLK + r32) * LDQ + cp * 64 + hi * 8;
#pragma unroll
    for (int d0 = 0; d0 < 4; ++d0) qr[d0] = *reinterpret_cast<const bf16x8*>(Qw + d0 * 16);
    const int sr = tid >> 4, sc = (tid & 15) * 8, vst0 = v_st(sr, sc), vst1 = v_st(32 + sr, sc);
    const int kr = tid >> 3, kcB = (tid & 7) * 16, kst = KSWZ(kr, kcB);
    const int vb0 = (int)(uintptr_t)V_lds + v_rd_base(lane);
    struct { bf16x8 vs0, vs1, ks0, ks1; } sr_[2];
    const char* Kc = K_lds + cp * SHM_K;
#define SLOAD(i, k0) do { sr_[i].vs0 = *reinterpret_cast<const bf16x8*>(&Vh[(size_t)((k0) + sr) * LDQ + sc]); sr_[i].vs1 = *reinterpret_cast<const bf16x8*>(&Vh[(size_t)((k0) + 32 + sr) * LDQ + sc]); \
    sr_[i].ks0 = *reinterpret_cast<const bf16x8*>(&Kh[(size_t)((k0) + kr) * LDQ + (tid & 7) * 8]); sr_[i].ks1 = *reinterpret_cast<const bf16x8*>(&Kh[(size_t)((k0) + kr) * LDQ + 64 + (tid & 7) * 8]); } while (0)
#define SWRITE(b, i) do { *(bf16x8*)(V_lds + (b) * SHM_V + vst0) = sr_[i].vs0; *(bf16x8*)(V_lds + (b) * SHM_V + vst1) = sr_[i].vs1; \
    *(bf16x8*)(K_lds + (b) * 2 * SHM_K + kst) = sr_[i].ks0; *(bf16x8*)(K_lds + (b) * 2 * SHM_K + SHM_K + kst) = sr_[i].ks1; } while (0)
#define SWAIT() asm volatile("s_waitcnt vmcnt(4)" ::: "memory")
#define RESC(a) do { if (__any((a) < 1.f)) { if (hi == 0) al_l[r32] = (a); asm volatile("s_waitcnt lgkmcnt(0)" ::: "memory"); \
    _Pragma("unroll") for (int d = 0; d < 4; ++d) _Pragma("unroll") for (int r = 0; r < 16; ++r) o[d][r] *= al_l[crow(r, hi)]; } } while (0)
    f32x16 pA0, pA1, pB0, pB1; float mnA, mnB, alA, alB; bf16x8 pa0, pa1, pa2, pa3; constexpr int NTL = TSEQ / KVBLK;
    constexpr int SE = 0, SO = 1;
    asm volatile("s_waitcnt vmcnt(0)" ::: "memory");
    SLOAD(SE, 0); asm volatile("s_waitcnt vmcnt(0)" ::: "memory"); SWRITE(0, SE); __syncthreads();
    qkt(pA0, pA1, Kc, qr, r32, hi); partialSM(pA0, pA1, m_reg, mnA, alA);
    SLOAD(SO, KVBLK); SLOAD(SE, 2 * KVBLK);
    SWAIT(); SWRITE(1, SO); __syncthreads();
    for (int j = 1; j + 1 < NTL; j += 2) {
        SBAR(); qkt(pB0, pB1, Kc + 2 * SHM_K, qr, r32, hi);
        finishSM(pA0, pA1, alA, l_reg, pa0, pa1, pa2, pa3); SBAR();
        SLOAD(SO, (j + 2) * KVBLK); SBAR();
        pv_d0(o, vb0, pa0, pa1, pa2, pa3); partialSM(pB0, pB1, m_reg, mnB, alB);
        __syncthreads(); SWAIT(); SWRITE(0, SE);
        RESC(alB); __syncthreads();
        SBAR(); qkt(pA0, pA1, Kc, qr, r32, hi);
        finishSM(pB0, pB1, alB, l_reg, pa0, pa1, pa2, pa3); SBAR();
        if (j + 3 < NTL) SLOAD(SE, (j + 3) * KVBLK); SBAR();
        pv_d0(o, vb0 + SHM_V, pa0, pa1, pa2, pa3); partialSM(pA0, pA1, m_reg, mnA, alA);
        __syncthreads(); SWAIT(); SWRITE(1, SO);
        RESC(alA); __syncthreads();
    }
    SBAR(); qkt(pB0, pB1, Kc + 2 * SHM_K, qr, r32, hi);
    finishSM(pA0, pA1, alA, l_reg, pa0, pa1, pa2, pa3); SBAR();
    pv_d0(o, vb0, pa0, pa1, pa2, pa3); partialSM(pB0, pB1, m_reg, mnB, alB);
    __syncthreads(); RESC(alB);
    finishSM(pB0, pB1, alB, l_reg, pa0, pa1, pa2, pa3); SBAR();
    pv_d0(o, vb0 + SHM_V, pa0, pa1, pa2, pa3);
    l_out = l_reg;
#undef SLOAD
#undef SWRITE
#undef SWAIT
#undef RESC
}
}

__device__ __forceinline__ void attn_phase(KP P, int l, unsigned char* shm) {
    const int tid = otid(), wid = tid >> 6, lane = tid & 63, r32 = lane & 31, hi = lane >> 5, cp = wid >> 2, wq = wid & 3;
    const u16* PDA = (const u16*)(P->ws + WS_PDA); u16* PDAw = (u16*)(P->ws + WS_PDA);
    float* li_l = (float*)(shm + 2 * att::SHM_V + 4 * att::SHM_K) + wid * 64;
    float* XCH = (float*)shm;
    const float lam_init = 0.8f - 0.6f * expf(-0.3f * (float)l);
    float lam;
    { const float* dl = P->in[19] + l * 256; const float p1 = wave_sum(dl[lane] * dl[64 + lane]), p2 = wave_sum(dl[128 + lane] * dl[192 + lane]); lam = expf(p1) - expf(p2) + lam_init; }
    float sg[4];
#pragma unroll
    for (int d0 = 0; d0 < 4; ++d0) sg[d0] = P->in[20][l * 128 + d0 * 32 + r32] * (1.f - lam_init);
    unsigned* qhead = (unsigned*)(P->ws + WS_Q) + l * 128;
    volatile int* slot = (volatile int*)(shm + 2 * att::SHM_V + 4 * att::SHM_K + 2048 + 64);
    const unsigned xcc = ((unsigned)__builtin_amdgcn_s_getreg((3 << 11) | 20)) & 7u;
    for (;;) {
        __syncthreads();
        if (tid == 0) { int item = -1;
            for (unsigned k = 0; k < 8u; ++k) { const unsigned qx = (xcc + k) & 7u; const unsigned idx = __hip_atomic_fetch_add(qhead + qx * 16, 1u, __ATOMIC_RELAXED, __HIP_MEMORY_SCOPE_AGENT);
                if (idx < 384u) { item = (int)(qx * 384u + idx); break; } }
            *slot = item; }
        __syncthreads();
        const int item = *slot; if (item < 0) break;
        const int qx = item / 384, idx = item - qx * 384;
        const int bh = (idx >> 6) * 8 + qx, qb = idx & 63, b = bh >> 2, h = bh & 3;
        const size_t tok0 = (size_t)b * TSEQ;
        f32x16 o[4]; float l_reg; float rli[16];
        __syncthreads();
        att::attn_pass(PDA + (tok0 + qb * 128) * DAC + h * 128, PDA + tok0 * DAC + 512 + h * 128, PDA + tok0 * DAC + 1024 + h * 128, (char*)shm, o, l_reg);
        asm volatile("s_waitcnt lgkmcnt(0)" ::: "memory");
        if (hi == 0) li_l[r32] = l_reg; asm volatile("s_waitcnt lgkmcnt(0)" ::: "memory");
#pragma unroll
        for (int r = 0; r < 16; ++r) rli[r] = 1.0f / li_l[crow(r, hi)];
        __syncthreads();
        if (cp == 1) {
#pragma unroll
            for (int r = 0; r < 16; ++r)
#pragma unroll
                for (int d0 = 0; d0 < 4; ++d0) XCH[((wq * 16 + r) * 4 + d0) * 64 + lane] = o[d0][r] * rli[r];
        }
        __syncthreads();
        if (cp == 0) {
            u16* yb = PDAw + (tok0 + qb * 128 + wq * 32 + 4 * hi) * DAC + h * 128 + r32; asm volatile("" : "+v"(yb));
#pragma unroll
            for (int r = 0; r < 16; ++r) {
                float v[4], ss = 0.f;
#pragma unroll
                for (int d0 = 0; d0 < 4; ++d0) { const float o1n = XCH[((wq * 16 + r) * 4 + d0) * 64 + lane];
                    v[d0] = o[d0][r] * rli[r] - lam * o1n; ss += v[d0] * v[d0]; }
#pragma unroll
                for (int m = 16; m >= 1; m >>= 1) ss += __shfl_xor(ss, m);
                const float rs = 1.0f / sqrtf(ss * (1.f / 128.f) + SUBLN_EPS_);
                u16* yr = yb + crow(r, 0) * DAC;
#pragma unroll
                for (int d0 = 0; d0 < 4; ++d0) yr[d0 * 32] = f2bf(v[d0] * rs * sg[d0]);
            }
        }
    }
}

__device__ __forceinline__ float allred4(float x) {
    { auto rr = __builtin_amdgcn_permlane16_swap(__float_as_uint(x), __float_as_uint(x), false, false); x = __uint_as_float(rr[0]) + __uint_as_float(rr[1]); }
    { auto rr = __builtin_amdgcn_permlane32_swap(__float_as_uint(x), __float_as_uint(x), false, false); x = __uint_as_float(rr[0]) + __uint_as_float(rr[1]); }
    return x;
}
#define DPPX(J) " row_newbcast:" #J " row_mask:0xf bank_mask:0xf\n"
#define SC_FMA(J) "v_fmac_f32_dpp %[acc0], %[x], %[s" #J "]" DPPX(J)
#define SC_FMB(J) "v_fmac_f32_dpp %[acc1], %[x], %[s" #J "]" DPPX(J)
#define SC_MUL(J) "v_mul_f32_dpp %[s" #J "], %[w], %[s" #J "]" DPPX(J)
#define SC_F1(J) "v_fmac_f32_dpp %[s" #J "], %[bb], %[sa]" DPPX(J)
#define SC_F2(J) "v_fmac_f32_dpp %[s" #J "], %[km], %[v]" DPPX(J)
#define SC_OA(J) "v_fmac_f32_dpp %[o0], %[r], %[s" #J "]" DPPX(J)
#define SC_OB(J) "v_fmac_f32_dpp %[o1], %[r], %[s" #J "]" DPPX(J)
#define ALL16(M) M(0) M(1) M(2) M(3) M(4) M(5) M(6) M(7) M(8) M(9) M(10) M(11) M(12) M(13) M(14) M(15)
#define EVEN8(M) M(0) M(2) M(4) M(6) M(8) M(10) M(12) M(14)
#define ODD8(M) M(1) M(3) M(5) M(7) M(9) M(11) M(13) M(15)
#define SIN_(J) [s##J] "v"(s##J),
#define SIO_(J) [s##J] "+v"(s##J),

__device__ __forceinline__ float fsig(float x) { return __builtin_amdgcn_rcpf(1.f + __expf(-x)); }
__device__ __forceinline__ void scan_load(int jn, int p, int lane, int b, int h, int d, const u16* __restrict__ PRW, u32x4 (&raw)[5][3]) {
    const int sl = lane >> 3, g_ = lane & 7, s = 8 * p + sl, tau = 32 * jn + s, t = d ? (TSEQ - 1 - tau) : tau; const size_t token = (size_t)b * TSEQ + t;
    const int cbase[5] = {64 * h, 512 + 64 * h, 1024 + 64 * h, 1536 + 64 * d, 1664 + 64 * d};
#pragma unroll
    for (int vec = 0; vec < 5; ++vec) {
        const u16* q = PRW + token * RWC + cbase[vec] + 8 * g_;
        raw[vec][0] = *(const u32x4*)q; raw[vec][1] = (u32x4){0u, 0u, 0u, 0u}; raw[vec][2] = (u32x4){0u, 0u, 0u, 0u};
        if (t > 0) raw[vec][1] = *(const u32x4*)(q - RWC); if (t < TSEQ - 1) raw[vec][2] = *(const u32x4*)(q + RWC);
    }
}
__device__ __forceinline__ void scan_produce(const u32x4 (&raw)[5][3], int jn, int p, int lane, int b, int h, int d, const u16* __restrict__ PRW, float* RK, unsigned char* ob, u16* WDXp, u16* ADXp,
                                             const float* MU_, const u16* Bw_, const u16* Ba_, const float (&bw)[4], const float (&ba)[4],
                                             const float* kkp_, const float* kap_, const float* rkp_) {
    float* R_ = (float*)ob; float* V_ = R_ + 2048; float* W_ = V_ + 2048; float* NKK_ = W_ + 2048; float* KM_ = NKK_ + 2048; float* BB_ = KM_ + 2048;
    const int sl = lane >> 3, g_ = lane & 7, s = 8 * p + sl, tau = 32 * jn + s, t = d ? (TSEQ - 1 - tau) : tau; const size_t token = (size_t)b * TSEQ + t;
    const int cbase[5] = {64 * h, 512 + 64 * h, 1024 + 64 * h, 1536 + 64 * d, 1664 + 64 * d};
    bf16x8 bfw[4][2], bfa[4][2];
    { const u16* Bw = Bw_; const u16* Ba = Ba_; asm volatile("" : "+v"(Bw), "+v"(Ba));
#pragma unroll
      for (int nb = 0; nb < 4; ++nb)
#pragma unroll
          for (int ks = 0; ks < 2; ++ks) { bfw[nb][ks] = *reinterpret_cast<const bf16x8*>(Bw + nb * 16 * 64 + 32 * ks); bfa[nb][ks] = *reinterpret_cast<const bf16x8*>(Ba + nb * 16 * 64 + 32 * ks); } }
#pragma unroll
    for (int vec = 0; vec < 5; ++vec) {
        float c[8], pv[8], nx[8], x[8]; unpack8(raw[vec][0], c); unpack8(raw[vec][1], pv); unpack8(raw[vec][2], nx);
#pragma unroll
        for (int e = 0; e < 8; ++e) { const float mp = MU_[vec * 128 + 8 * g_ + e], mn = MU_[vec * 128 + 64 + 8 * g_ + e]; x[e] = c[e] + mp * (pv[e] - c[e]) + mn * (nx[e] - c[e]); }
        if (vec < 3) { float* dst = (vec == 0 ? R_ : vec == 1 ? KM_ : V_) + s * 64 + 8 * g_;
            *(f32x4*)dst = (f32x4){x[0], x[1], x[2], x[3]}; *(f32x4*)(dst + 4) = (f32x4){x[4], x[5], x[6], x[7]}; }
        else { if (vec == 3) {
#pragma unroll
                for (int e = 0; e < 8; ++e) x[e] = 1.f - 2.f * __builtin_amdgcn_rcpf(1.f + __expf(2.f * x[e])); }
            *(u32x4*)((vec == 3 ? WDXp : ADXp) + sl * 72 + 8 * g_) = pack8(x); }
    }
    asm volatile("s_waitcnt lgkmcnt(0)" ::: "memory");
    { const int fr = lane & 15, fq = lane >> 4;
      bf16x8 aw[2], aa[2];
#pragma unroll
      for (int ks = 0; ks < 2; ++ks) { aw[ks] = *reinterpret_cast<const bf16x8*>(WDXp + fr * 72 + 32 * ks + 8 * fq); aa[ks] = *reinterpret_cast<const bf16x8*>(ADXp + fr * 72 + 32 * ks + 8 * fq); }
#pragma unroll
      for (int nb = 0; nb < 4; ++nb) {
          f32x4 cw = {0.f, 0.f, 0.f, 0.f}, ca = {0.f, 0.f, 0.f, 0.f};
#pragma unroll
          for (int ks = 0; ks < 2; ++ks) { cw = __builtin_amdgcn_mfma_f32_16x16x32_bf16(aw[ks], bfw[nb][ks], cw, 0, 0, 0); ca = __builtin_amdgcn_mfma_f32_16x16x32_bf16(aa[ks], bfa[nb][ks], ca, 0, 0, 0); }
          if (fq < 2) {
#pragma unroll
              for (int jj = 0; jj < 4; ++jj) { const int srow = 8 * p + 4 * fq + jj, n = 16 * nb + fr;
                  W_[srow * 64 + n] = __expf(-0.60653065971263342f * fsig(cw[jj] + bw[nb]));
                  BB_[srow * 64 + n] = fsig(ca[jj] + ba[nb]); } }
      } }
    asm volatile("s_waitcnt lgkmcnt(0)" ::: "memory");
    { float k[8], a[8], r[8], kkr[8], ss = 0.f, kkc[8], kac[8], rkc[8];
      { const float* kkp = kkp_; const float* kap = kap_; const float* rkp2 = rkp_; asm volatile("" : "+v"(kkp), "+v"(kap), "+v"(rkp2));
        const f32x4 q0 = *(const f32x4*)kkp, q1 = *(const f32x4*)(kkp + 4), q2 = *(const f32x4*)kap, q3 = *(const f32x4*)(kap + 4), q4 = *(const f32x4*)rkp2, q5 = *(const f32x4*)(rkp2 + 4);
#pragma unroll
        for (int e = 0; e < 4; ++e) { kkc[e] = q0[e]; kkc[4 + e] = q1[e]; kac[e] = q2[e]; kac[4 + e] = q3[e]; rkc[e] = q4[e]; rkc[4 + e] = q5[e]; } }
      { const f32x4 k0 = *(const f32x4*)(KM_ + s * 64 + 8 * g_), k1 = *(const f32x4*)(KM_ + s * 64 + 8 * g_ + 4), a0 = *(const f32x4*)(BB_ + s * 64 + 8 * g_), a1 = *(const f32x4*)(BB_ + s * 64 + 8 * g_ + 4),
                    r0 = *(const f32x4*)(R_ + s * 64 + 8 * g_), r1 = *(const f32x4*)(R_ + s * 64 + 8 * g_ + 4);
#pragma unroll
        for (int e = 0; e < 4; ++e) { k[e] = k0[e]; k[4 + e] = k1[e]; a[e] = a0[e]; a[4 + e] = a1[e]; r[e] = r0[e]; r[4 + e] = r1[e]; } }
#pragma unroll
      for (int e = 0; e < 8; ++e) { kkr[e] = k[e] * kkc[e]; ss += kkr[e] * kkr[e]; }
      ss += __shfl_xor(ss, 1); ss += __shfl_xor(ss, 2); ss += __shfl_xor(ss, 4);
      const float inv = __builtin_amdgcn_rsqf(fmaxf(ss, 1e-24f));
      float nk[8], bb[8], km[8], rkp = 0.f;
#pragma unroll
      for (int e = 0; e < 8; ++e) { const float kk = kkr[e] * inv; nk[e] = -kk; bb[e] = kk * a[e]; km[e] = k[e] * (1.f + (a[e] - 1.f) * kac[e]); rkp += r[e] * km[e] * rkc[e]; }
      rkp += __shfl_xor(rkp, 1); rkp += __shfl_xor(rkp, 2); rkp += __shfl_xor(rkp, 4);
      *(f32x4*)(NKK_ + s * 64 + 8 * g_) = (f32x4){nk[0], nk[1], nk[2], nk[3]}; *(f32x4*)(NKK_ + s * 64 + 8 * g_ + 4) = (f32x4){nk[4], nk[5], nk[6], nk[7]};
      *(f32x4*)(BB_ + s * 64 + 8 * g_) = (f32x4){bb[0], bb[1], bb[2], bb[3]}; *(f32x4*)(BB_ + s * 64 + 8 * g_ + 4) = (f32x4){bb[4], bb[5], bb[6], bb[7]};
      *(f32x4*)(KM_ + s * 64 + 8 * g_) = (f32x4){km[0], km[1], km[2], km[3]}; *(f32x4*)(KM_ + s * 64 + 8 * g_ + 4) = (f32x4){km[4], km[5], km[6], km[7]};
      if (g_ == 0) RK[((size_t)d * NT + token) * 8 + h] = rkp; }
}
__device__ __forceinline__ void scan_writeout(int jo, int p, int lane, int b, int h, int d, const float* O_, u16* OD) {
    const int sl = lane >> 3, g_ = lane & 7, s = 8 * p + sl, tau = 32 * jo + s, t = d ? (TSEQ - 1 - tau) : tau; const size_t token = (size_t)b * TSEQ + t;
    float f[8]; const f32x4 a0 = *(const f32x4*)(O_ + s * 64 + 8 * g_), a1 = *(const f32x4*)(O_ + s * 64 + 8 * g_ + 4);
#pragma unroll
    for (int e = 0; e < 4; ++e) { f[e] = a0[e]; f[4 + e] = a1[e]; }
    *(u32x4*)(OD + token * DM + d * 512 + 64 * h + 8 * g_) = pack8(f);
}

__device__ __forceinline__ void scan_phase(KP P, int l, unsigned char* shm) {
    const int tid = otid(), wid = tid >> 6, lane = tid & 63;
    constexpr int NCH = TSEQ / 32, OB_STRIDE = 49152, OO_BASE = 98304, PT_BASE = 114688, MU_BASE = 133120;
    float* MU_ = (float*)(shm + MU_BASE);
    const u16* PRW = (const u16*)(P->ws + WS_PRW); u16* OD = (u16*)(P->ws + WS_XB); float* RK = (float*)(P->ws + WS_RK);
    const int p = wid & 3; u16* WDXp = (u16*)(shm + PT_BASE + p * 4608); u16* ADXp = WDXp + 16 * 72;
    for (int u = blockIdx.x; u < 192; u += gridDim.x) {
        const int b = u >> 4, h = (u >> 1) & 7, d = u & 1;
        __syncthreads();
        for (int i = tid; i < 640; i += 512) { const int vec = i >> 7, which = (i >> 6) & 1, n = i & 63;
            const int cb = vec == 0 ? 64 * h : vec == 1 ? 512 + 64 * h : vec == 2 ? 1024 + 64 * h : vec == 3 ? 1536 + 64 * d : 1664 + 64 * d;
            MU_[i] = P->in[8][(size_t)(l * 2 + which) * RWC + cb + n]; }
        float bw[4], ba[4]; const u16* Bw; const u16* Ba; const float* kkp; const float* kap; const float* rkp;
        { const int fr = lane & 15, fq = lane >> 4, g_ = lane & 7;
          Bw = (const u16*)(P->ws + WS_WUP) + ((size_t)(l * 2 + d) * 512 + 64 * h + fr) * 64 + 8 * fq;
          Ba = (const u16*)(P->ws + WS_AUP) + ((size_t)(l * 2 + d) * 512 + 64 * h + fr) * 64 + 8 * fq;
#pragma unroll
          for (int nb = 0; nb < 4; ++nb) {
              bw[nb] = P->in[10][(size_t)(l * 2 + d) * 512 + 64 * h + 16 * nb + fr]; ba[nb] = P->in[12][(size_t)(l * 2 + d) * 512 + 64 * h + 16 * nb + fr]; }
          kkp = P->in[14] + l * 512 + 64 * h + 8 * g_; kap = P->in[15] + l * 512 + 64 * h + 8 * g_; rkp = P->in[16] + l * 512 + 64 * h + 8 * g_; }
        float s0 = 0, s1 = 0, s2 = 0, s3 = 0, s4 = 0, s5 = 0, s6 = 0, s7 = 0, s8 = 0, s9 = 0, s10 = 0, s11 = 0, s12 = 0, s13 = 0, s14 = 0, s15 = 0;
        __syncthreads();
        u32x4 raw[5][3];
        if (wid >= 4) { scan_load(0, p, lane, b, h, d, PRW, raw); scan_produce(raw, 0, p, lane, b, h, d, PRW, RK, shm, WDXp, ADXp, MU_, Bw, Ba, bw, ba, kkp, kap, rkp); scan_load(1, p, lane, b, h, d, PRW, raw); }
        __syncthreads();
        for (int j = 0; j < NCH; ++j) {
            unsigned char* ob = shm + (j & 1) * OB_STRIDE; float* O_ = (float*)(shm + OO_BASE + (j & 1) * 8192);
            if (wid < 4) {
                const float* R_ = (const float*)ob; const float* V_ = R_ + 2048; const float* W_ = V_ + 2048; const float* NKK_ = W_ + 2048; const float* KM_ = NKK_ + 2048; const float* BB_ = KM_ + 2048;
                float pn[4], pw[4], pb[4], pk[4], pr[4], pv[4];
#pragma unroll
                for (int i = 0; i < 4; ++i) { pn[i] = NKK_[i * 64 + lane]; pw[i] = W_[i * 64 + lane]; pb[i] = BB_[i * 64 + lane]; pk[i] = KM_[i * 64 + lane]; pr[i] = R_[i * 64 + lane]; pv[i] = V_[i * 64 + 16 * wid + (lane & 15)]; }
                for (int st = 0; st < 32; st += 4) {
#pragma unroll
                    for (int i = 0; i < 4; ++i) {
                        const float cn = pn[i], cw = pw[i], cb_ = pb[i], ck = pk[i], cr = pr[i], cv = pv[i];
                        { const int sn = st + 4 + i;
                          pn[i] = NKK_[sn * 64 + lane]; pw[i] = W_[sn * 64 + lane]; pb[i] = BB_[sn * 64 + lane]; pk[i] = KM_[sn * 64 + lane]; pr[i] = R_[sn * 64 + lane]; pv[i] = V_[sn * 64 + 16 * wid + (lane & 15)]; }
                        float sa0 = 0.f, sa1 = 0.f;
                        asm volatile("s_nop 1\n" EVEN8(SC_FMA) ODD8(SC_FMB) "s_nop 1\n"
                                     : [acc0] "+v"(sa0), [acc1] "+v"(sa1) : ALL16(SIN_) [x] "v"(cn));
                        const float sa = allred4(sa0 + sa1);
                        float o0 = 0.f, o1 = 0.f;
                        asm volatile("s_nop 1\n" ALL16(SC_MUL) ALL16(SC_F1) ALL16(SC_F2) EVEN8(SC_OA) ODD8(SC_OB) "s_nop 1\n"
                                     : ALL16(SIO_) [o0] "+v"(o0), [o1] "+v"(o1)
                                     : [sa] "v"(sa), [v] "v"(cv), [w] "v"(cw), [bb] "v"(cb_), [km] "v"(ck), [r] "v"(cr));
                        const float oo = allred4(o0 + o1);
                        O_[(st + i) * 64 + 16 * wid + (lane & 15)] = oo;
                    }
                }
            } else {
                if (j + 1 < NCH) scan_produce(raw, j + 1, p, lane, b, h, d, PRW, RK, shm + ((j + 1) & 1) * OB_STRIDE, WDXp, ADXp, MU_, Bw, Ba, bw, ba, kkp, kap, rkp);
                if (j + 2 < NCH) scan_load(j + 2, p, lane, b, h, d, PRW, raw);
                if (j >= 1) scan_writeout(j - 1, p, lane, b, h, d, (const float*)(shm + OO_BASE + ((j - 1) & 1) * 8192), OD);
            }
            __syncthreads();
        }
        if (wid >= 4) scan_writeout(NCH - 1, p, lane, b, h, d, (const float*)(shm + OO_BASE + ((NCH - 1) & 1) * 8192), OD);
    }
}

__device__ __forceinline__ float red32(float x) {
#pragma unroll
    for (int m = 16; m >= 1; m >>= 1) x += __shfl_xor(x, m);
    return x;
}
__device__ __forceinline__ void post_phase(KP P, int l, unsigned char* shm) {
    const int tid = otid(), wid = tid >> 6, lane = tid & 63, r32 = lane & 31, hi = lane >> 5, h = wid;
    u16* GS = (u16*)shm;
    float* G = (float*)(shm + 17408) + wid * (64 * 68);
    const u16* PRW = (const u16*)(P->ws + WS_PRW); const u16* PDA = (const u16*)(P->ws + WS_PDA); const float* RK = (const float*)(P->ws + WS_RK); u16* Y = (u16*)(P->ws + WS_XB);
    const u16* gup0 = (const u16*)(P->ws + WS_GUP) + ((size_t)l * 512 + 64 * h + r32) * 128 + 8 * hi;
    const int s_ = tid >> 3, g_ = tid & 7, ls = lane >> 3, lg = lane & 7;
    const float* mgp0 = P->in[8] + (size_t)(l * 2 + 0) * RWC + 1792 + 16 * g_;
    float gng[8], gnb[8], mvp[8], mvn[8];
#pragma unroll
    for (int e = 0; e < 8; ++e) { const int c = 64 * h + 8 * lg + e; gng[e] = P->in[17][l * 512 + c]; gnb[e] = P->in[18][l * 512 + c];
        mvp[e] = P->in[8][(size_t)(l * 2 + 0) * RWC + 1024 + c]; mvn[e] = P->in[8][(size_t)(l * 2 + 1) * RWC + 1024 + c]; }
    for (int it = blockIdx.x; it < NT / 64; it += gridDim.x) {
        const size_t tok0 = (size_t)it * 64;
        __syncthreads();
        { const size_t token = tok0 + s_; const int t = (int)(token & (TSEQ - 1));
          const float* mgp = mgp0; asm volatile("" : "+v"(mgp)); const float* mgn = mgp + RWC;
#pragma unroll
          for (int hf = 0; hf < 2; ++hf) {
              const u16* p = PRW + token * RWC + 1792 + 16 * g_ + 8 * hf;
              const u32x4 wc = *(const u32x4*)p; u32x4 wp = {0u, 0u, 0u, 0u}, wn = {0u, 0u, 0u, 0u};
              if (t > 0) wp = *(const u32x4*)(p - RWC); if (t < TSEQ - 1) wn = *(const u32x4*)(p + RWC);
              float c[8], pv[8], nx[8], x[8]; unpack8(wc, c); unpack8(wp, pv); unpack8(wn, nx);
#pragma unroll
              for (int e = 0; e < 8; ++e) { const float xs = c[e] + mgp[8 * hf + e] * (pv[e] - c[e]) + mgn[8 * hf + e] * (nx[e] - c[e]); x[e] = fsig(xs); }
              *(u32x4*)(GS + s_ * 136 + 16 * g_ + 8 * hf) = pack8(x);
          } }
        __syncthreads();
        { f32x16 acc[2][2];
#pragma unroll
          for (int mb = 0; mb < 2; ++mb)
#pragma unroll
              for (int nb = 0; nb < 2; ++nb) acc[mb][nb] = f32x16{};
          const u16* gup = gup0; asm volatile("" : "+v"(gup));
#pragma unroll
          for (int ks = 0; ks < 8; ++ks) {
              const bf16x8 b0 = *reinterpret_cast<const bf16x8*>(gup + 16 * ks), b1 = *reinterpret_cast<const bf16x8*>(gup + 32 * 128 + 16 * ks);
#pragma unroll
              for (int mb = 0; mb < 2; ++mb) { const bf16x8 a = *reinterpret_cast<const bf16x8*>(GS + (32 * mb + r32) * 136 + 16 * ks + 8 * hi);
                  acc[mb][0] = __builtin_amdgcn_mfma_f32_32x32x16_bf16(a, b0, acc[mb][0], 0, 0, 0); acc[mb][1] = __builtin_amdgcn_mfma_f32_32x32x16_bf16(a, b1, acc[mb][1], 0, 0, 0); } }
#pragma unroll
          for (int mb = 0; mb < 2; ++mb)
#pragma unroll
              for (int nb = 0; nb < 2; ++nb)
#pragma unroll
                  for (int i = 0; i < 16; ++i) G[(32 * mb + crow(i, hi)) * 68 + 32 * nb + r32] = acc[mb][nb][i]; }
        asm volatile("s_waitcnt lgkmcnt(0)" ::: "memory");
#pragma unroll 2
        for (int q = 0; q < 8; ++q) {
            const int srow = 8 * q + ls; const size_t token = tok0 + srow; const int t = (int)(token & (TSEQ - 1));
            const u32x4 wo0 = *(const u32x4*)(Y + token * DM + 64 * h + 8 * lg), wo1 = *(const u32x4*)(Y + token * DM + 512 + 64 * h + 8 * lg);
            const u32x4 yda = *(const u32x4*)(PDA + token * DAC + 64 * h + 8 * lg);
            const u16* pvp = PRW + token * RWC + 1024 + 64 * h + 8 * lg;
            const u32x4 wc = *(const u32x4*)pvp; u32x4 wp = {0u, 0u, 0u, 0u}, wn = {0u, 0u, 0u, 0u};
            if (t > 0) wp = *(const u32x4*)(pvp - RWC); if (t < TSEQ - 1) wn = *(const u32x4*)(pvp + RWC);
            const float rk = RK[token * 8 + h] + RK[((size_t)NT + token) * 8 + h];
            const f32x4 g0 = *(const f32x4*)(G + srow * 68 + 8 * lg), g1 = *(const f32x4*)(G + srow * 68 + 8 * lg + 4);
            float o0[8], o1[8], vc[8], vp[8], vn[8], x[8], y[8]; unpack8(wo0, o0); unpack8(wo1, o1); unpack8(wc, vc); unpack8(wp, vp); unpack8(wn, vn);
            float sm = 0.f;
#pragma unroll
            for (int e = 0; e < 8; ++e) { x[e] = o0[e] + o1[e]; sm += x[e]; }
            sm += __shfl_xor(sm, 1); sm += __shfl_xor(sm, 2); sm += __shfl_xor(sm, 4);
            const float mu = sm * (1.f / 64.f); float sq = 0.f;
#pragma unroll
            for (int e = 0; e < 8; ++e) { x[e] -= mu; sq += x[e] * x[e]; }
            sq += __shfl_xor(sq, 1); sq += __shfl_xor(sq, 2); sq += __shfl_xor(sq, 4);
            const float rs = 1.0f / sqrtf(sq * (1.f / 64.f) + GN_EPS_);
#pragma unroll
            for (int e = 0; e < 8; ++e) { const float vs = vc[e] + mvp[e] * (vp[e] - vc[e]) + mvn[e] * (vn[e] - vc[e]); const float gg = e < 4 ? g0[e] : g1[e - 4];
                y[e] = (x[e] * rs * gng[e] + gnb[e] + rk * vs) * gg; }
            *(u32x4*)(Y + token * DM + 64 * h + 8 * lg) = pack8(y); *(u32x4*)(Y + token * DM + 512 + 64 * h + 8 * lg) = yda;
        }
    }
}

#define LP launder_kp(P)
__global__ void __launch_bounds__(512, 2) fwd_megakernel(Params Praw) {
    extern __shared__ __attribute__((aligned(16))) unsigned char shm[];
    cg::grid_group grid = cg::this_grid();
    KP P = (KP)__builtin_amdgcn_kernarg_segment_ptr();
    unsigned char* ws = LP->ws;
    float* X = LP->out; u16* XB = (u16*)(ws + WS_XB); u16* HB = (u16*)(ws + WS_BIG);
    phase0(LP, shm);
    grid.sync();
    for (int l = 0; l < DEPTH_; ++l) {
        { EpiSwiglu E; E.H = HB; run_gemm(shm, XB, (const u16*)(ws + WS_WGU) + (size_t)(l * 2 + 0) * NGU * DM, NGU, DM, E); }
        grid.sync();
        { EpiResid E; E.X = X; E.scale = 0.5f; E.S0 = l == 0 ? LP->in[0] : X; E.S1 = l == 0 ? LP->in[1] : X; E.SB = l == 0 ? nullptr : XB; run_gemm(shm, HB, (const u16*)(ws + WS_WDN) + (size_t)(l * 2 + 0) * DM * DFF, DM, DFF, E); }
        grid.sync();
        ln_phase<0>(X, XB, LP->in[2] + (l * 3 + 0) * DM, LP->in[3] + (l * 3 + 0) * DM);
        grid.sync();
        { EpiProj E; E.PRW = (u16*)(ws + WS_PRW); E.PDA = (u16*)(ws + WS_PDA); E.rt = (const float*)(ws + WS_ROPE); run_gemm(shm, XB, (const u16*)(ws + WS_WIN) + (size_t)l * NINP * DM, NINP, DM, E); }
        grid.sync();
        scan_phase(LP, l, shm);
        attn_phase(LP, l, shm);
        grid.sync();
#ifndef NO_POST
        post_phase(LP, l, shm);
#endif
        grid.sync();
        { EpiResid E; E.X = X; E.scale = 1.0f; E.S0 = X; E.S1 = X; E.SB = nullptr; run_gemm(shm, XB, (const u16*)(ws + WS_WOUT) + (size_t)l * DM * DM, DM, DM, E); }
        grid.sync();
        ln_phase<1>(X, XB, LP->in[2] + (l * 3 + 1) * DM, LP->in[3] + (l * 3 + 1) * DM);
        grid.sync();
        { EpiSwiglu E; E.H = HB; run_gemm(shm, XB, (const u16*)(ws + WS_WGU) + (size_t)(l * 2 + 1) * NGU * DM, NGU, DM, E); }
        grid.sync();
        { EpiResid E; E.X = X; E.scale = 0.5f; E.S0 = X; E.S1 = X; E.SB = XB; run_gemm(shm, HB, (const u16*)(ws + WS_WDN) + (size_t)(l * 2 + 1) * DM * DFF, DM, DFF, E); }
        grid.sync();
        if (l == DEPTH_ - 1) ln_phase<2>(X, XB, LP->in[2] + (l * 3 + 2) * DM, LP->in[3] + (l * 3 + 2) * DM);
        else ln_phase<1>(X, XB, LP->in[2] + (l * 3 + 2) * DM, LP->in[3] + (l * 3 + 2) * DM);
        grid.sync();
    }
}

extern "C" void kernel_launch(void* const* d_in, const int* in_sizes, int n_in, void* d_out, int out_size, void* d_ws, size_t ws_size, hipStream_t stream) {
    static int grid_blocks = 0;
    if (!grid_blocks) {
        int dev = 0, cus = 0, per_cu = 0;
        (void)hipGetDevice(&dev);
        (void)hipDeviceGetAttribute(&cus, hipDeviceAttributeMultiprocessorCount, dev);
        if (hipFuncSetAttribute((const void*)fwd_megakernel, hipFuncAttributeMaxDynamicSharedMemorySize, LDS_BYTES) != hipSuccess) fprintf(stderr, "kernel_launch: hipFuncSetAttribute failed\n");
        (void)hipOccupancyMaxActiveBlocksPerMultiprocessor(&per_cu, (const void*)fwd_megakernel, 512, LDS_BYTES);
        if (per_cu < 1) per_cu = 1;
        grid_blocks = cus * per_cu;
        if (grid_blocks > 256) grid_blocks = 256;
        if (n_in != 21 || ws_size < WS_END) fprintf(stderr, "kernel_launch: unexpected n_in %d / ws_size %zu (need %zu)\n", n_in, ws_size, (size_t)WS_END);
    }
    Params p{};
    for (int i = 0; i < 21; ++i) p.in[i] = (const float*)d_in[i];
    p.out = (float*)d_out; p.ws = (unsigned char*)d_ws;
    for (int i = 0; i < 32; ++i) p.inv[i] = powf(10000.0f, -(float)(2 * i) / 64.0f);
    void* args[] = {&p};
    hipError_t e = hipLaunchCooperativeKernel((const void*)fwd_megakernel, dim3(grid_blocks), dim3(512), args, LDS_BYTES, stream);
    if (e != hipSuccess) fprintf(stderr, "cooperative launch failed: %s (grid %d)\n", hipGetErrorString(e), grid_blocks);
}
#ifdef TESTK
__global__ void __launch_bounds__(512, 2) tk_phase0(Params Praw) { KP P = (KP)__builtin_amdgcn_kernarg_segment_ptr(); extern __shared__ __attribute__((aligned(16))) unsigned char shm[]; phase0(P, shm); }
__global__ void __launch_bounds__(512, 2) tk_gemm_swiglu(Params Praw) { KP P = (KP)__builtin_amdgcn_kernarg_segment_ptr(); extern __shared__ __attribute__((aligned(16))) unsigned char shm[]; EpiSwiglu E; E.H = (u16*)P->ws; run_gemm(shm, (u16*)P->ws, (const u16*)P->ws, NGU, DM, E); }
__global__ void __launch_bounds__(512, 2) tk_gemm_resid(Params Praw) { KP P = (KP)__builtin_amdgcn_kernarg_segment_ptr(); extern __shared__ __attribute__((aligned(16))) unsigned char shm[]; EpiResid E; E.X = P->out; E.scale = 0.5f; run_gemm(shm, (u16*)P->ws, (const u16*)P->ws, DM, DFF, E); }
__global__ void __launch_bounds__(512, 2) tk_gemm_proj(Params Praw) { KP P = (KP)__builtin_amdgcn_kernarg_segment_ptr(); extern __shared__ __attribute__((aligned(16))) unsigned char shm[]; EpiProj E; E.PRW = (u16*)P->ws; E.PDA = (u16*)P->ws; run_gemm(shm, (u16*)P->ws, (const u16*)P->ws, NINP, DM, E); }
__global__ void __launch_bounds__(512, 2) tk_ln(Params Praw) { KP P = (KP)__builtin_amdgcn_kernarg_segment_ptr(); ln_phase<0>(P->out, (u16*)P->ws, P->in[2], P->in[3]); }
__global__ void __launch_bounds__(512, 2) tk_rope(Params Praw) { KP P = (KP)__builtin_amdgcn_kernarg_segment_ptr(); rope_phase((u16*)P->ws, (const float*)P->ws); }
__global__ void __launch_bounds__(512, 2) tk_attn(Params Praw) { KP P = (KP)__builtin_amdgcn_kernarg_segment_ptr(); extern __shared__ __attribute__((aligned(16))) unsigned char shm[]; attn_phase(P, 1, shm); }
__global__ void __launch_bounds__(512, 2) tk_scan(Params Praw) { KP P = (KP)__builtin_amdgcn_kernarg_segment_ptr(); extern __shared__ __attribute__((aligned(16))) unsigned char shm[]; scan_phase(P, 1, shm); }
__global__ void __launch_bounds__(512, 2) tk_post(Params Praw) { KP P = (KP)__builtin_amdgcn_kernarg_segment_ptr(); extern __shared__ __attribute__((aligned(16))) unsigned char shm[]; post_phase(P, 1, shm); }
#endif
#ifdef TESTK
__global__ void __launch_bounds__(512, 2) tk_attn_pass_only(Params Praw) { KP P = (KP)__builtin_amdgcn_kernarg_segment_ptr(); extern __shared__ __attribute__((aligned(16))) unsigned char shm[];
  f32x16 o[4]; float l_reg; const u16* PDA = (const u16*)P->ws;
  att::attn_pass(PDA + blockIdx.x * 1000, PDA + 512, PDA + 1024, (char*)shm, o, l_reg);
  float* out = P->out + threadIdx.x * 65;
  for (int d = 0; d < 4; ++d) for (int r = 0; r < 16; ++r) out[d * 16 + r] = o[d][r] * l_reg;
}
#endif
```

```cpp
#include <hip/hip_runtime.h>
#include <hip/hip_cooperative_groups.h>
#include <cstdio>
#include <cstdint>
#include <cmath>
namespace cg = cooperative_groups;
__device__ __forceinline__ int otid();

namespace pg8 {
#define PG8_LAS __attribute__((address_space(3)))
typedef unsigned short bf16_t;
typedef short bf16x8 __attribute__((ext_vector_type(8)));
typedef float f32x4 __attribute__((ext_vector_type(4)));
typedef unsigned u32x4 __attribute__((ext_vector_type(4)));
constexpr int BM = 256, BK = 64, HALF = 128, HTB = HALF * BK * 2  , STAGE_BYTES = 8 * HTB, NXCD = 8, WGM = 8;

__host__ __device__ __forceinline__ int lds_byte(int r, int c) { const int st = (r >> 4) * 2 + (c >> 5), rr = r & 15, cc = c & 31, ob = rr * 64 + cc * 2; return st * 1024 + (ob ^ (((ob >> 9) & 1) << 5)); }
__host__ __device__ __forceinline__ void stage_rc(int b, int& R, int& C) { const int st = b / 1024, sb = b % 1024, swz = sb ^ (((sb >> 9) & 1) << 5); R = (st >> 1) * 16 + swz / 64; C = (st & 1) * 32 + (swz % 64) / 2; }
__host__ __device__ __forceinline__ int perm32(int rho) { const int n = rho >> 4, i = rho & 15; return 8 * (i >> 2) + 4 * n + (i & 3); }

struct Unit { int pm, pn; };
struct Gemm { const bf16_t* A; const bf16_t* Bt; int M, N, K; };

struct StaticOrder {
    int nM, nN, nwg, G, c;
    __host__ __device__ void init(int M, int N, int G_, int c_) { nM = M / BM; nN = N / BM; nwg = nM * nN; G = G_; c = c_; }
    __host__ __device__ bool next(int i, Unit& u) const {
        const long L = (long)i * G + c; if (L >= nwg) return false;
        int wgid = (int)L; { const int q = nwg / NXCD, r = nwg % NXCD, xcd = wgid % NXCD, off = wgid / NXCD; wgid = (xcd < r ? xcd * (q + 1) : r * (q + 1) + (xcd - r) * q) + off; }
        const int nig = WGM * nN, gid = wgid / nig, fm = gid * WGM, gsz = (nM - fm) < WGM ? (nM - fm) : WGM;
        u.pm = fm + ((wgid % nig) % gsz); u.pn = (wgid % nig) / gsz; return true;
    }
    __device__ __forceinline__ void a_ready(const Unit&) const {}
    __device__ __forceinline__ void done(const Unit&) const {}
};
__device__ __forceinline__ unsigned cvt_pk_bf16(float lo, float hi) { unsigned r; asm volatile("v_cvt_pk_bf16_f32 %0, %1, %2" : "=v"(r) : "v"(lo), "v"(hi)); return r; }

template <class Epi, class Sched, bool ALIGN_EPI = false, bool SP2 = false>
__device__ __forceinline__ void gemm_phase(PG8_LAS unsigned char* lds, const Gemm g, const Sched& S, const Epi& E) {
    const int tid = otid(), wid = __builtin_amdgcn_readfirstlane(tid >> 6), lane = tid & 63, wr = wid >> 2, wc = wid & 3, fr = lane & 15, fq = lane >> 4;
    const int K = g.K, nt = K / BK;
    unsigned voffA[2], voffB[2];
#pragma unroll
    for (int i = 0; i < 2; ++i) { int R, C; stage_rc(tid * 16 + i * 8192, R, C); const int Rb = Epi::PERM ? ((R & ~31) + perm32(R & 31)) : R;
        voffA[i] = (unsigned)(R * K + C) * 2u; voffB[i] = (unsigned)(Rb * K + C) * 2u; }
    const size_t kstep = (size_t)(BK * 2);
    const size_t hstep = (size_t)HALF * K * 2;
    const size_t tstep = 2 * hstep;
    const unsigned ldsw = (unsigned)wid * 1024u;
    const int aoff = lds_byte(wr * 64 + fr, fq * 8), boff = lds_byte(wc * 32 + fr, fq * 8);
#define PG8_SA(b, h) (((b) * 2 + (h)) * HTB)
#define PG8_SB(b, h) ((4 + (b) * 2 + (h)) * HTB)
#define PG8_STAGE(bufoff, gbase, voff) do { _Pragma("unroll") for (int _i = 0; _i < 2; ++_i) \
        __builtin_amdgcn_global_load_lds((const unsigned*)((const char*)(gbase) + (voff)[_i]), (PG8_LAS unsigned*)(lds + (bufoff) + ldsw + _i * 8192), 16, 0, 0); } while (0)
#define PG8_LDA(dst, b, h) do { _Pragma("unroll") for (int m = 0; m < 4; ++m) _Pragma("unroll") for (int k = 0; k < 2; ++k) dst[m][k] = *(const PG8_LAS bf16x8*)(lds + PG8_SA(b, h) + aoff + m * 2048 + k * 1024); } while (0)
#define PG8_LDB(dst, b, h) do { _Pragma("unroll") for (int n = 0; n < 2; ++n) _Pragma("unroll") for (int k = 0; k < 2; ++k) dst[n][k] = *(const PG8_LAS bf16x8*)(lds + PG8_SB(b, h) + boff + n * 2048 + k * 1024); } while (0)
#define PG8_MMA(ai, bj, At, Bt) do { __builtin_amdgcn_s_setprio(1); _Pragma("unroll") for (int m = 0; m < 4; ++m) _Pragma("unroll") for (int n = 0; n < 2; ++n) _Pragma("unroll") for (int k = 0; k < 2; ++k) \
        acc[ai][bj][m][n] = __builtin_amdgcn_mfma_f32_16x16x32_bf16(Bt[n][k], At[m][k], acc[ai][bj][m][n], 0, 0, 0); __builtin_amdgcn_s_setprio(0); } while (0)
#define PG8_WAIT_V(n) asm volatile("s_waitcnt vmcnt(" #n ")" ::: "memory")
#define PG8_WAIT_L(n) asm volatile("s_waitcnt lgkmcnt(" #n ")" ::: "memory")
#define PG8_BAR __builtin_amdgcn_s_barrier()
#define PG8_SCHED __builtin_amdgcn_sched_barrier(0)
    Unit cur, nxt; int ui = 0;
    if (!S.next(0, cur)) return;
    f32x4 acc[2][2][4][2];
#pragma unroll
    for (int a = 0; a < 2; ++a)
#pragma unroll
        for (int b = 0; b < 2; ++b)
#pragma unroll
            for (int m = 0; m < 4; ++m)
#pragma unroll
                for (int n = 0; n < 2; ++n) acc[a][b][m][n] = (f32x4){0.f, 0.f, 0.f, 0.f};
    bf16x8 At[4][2], B0[2][2], B1[2][2];
    const char* cA = (const char*)g.A + (size_t)cur.pm * tstep; const char* cB = (const char*)g.Bt + (size_t)cur.pn * tstep;
    S.a_ready(cur);
    if constexpr (SP2) {
        PG8_STAGE(PG8_SB(0, 0), cB, voffB); PG8_STAGE(PG8_SB(0, 1), cB + hstep, voffB); PG8_STAGE(PG8_SA(0, 0), cA, voffA); PG8_STAGE(PG8_SA(0, 1), cA + hstep, voffA);
        if (wr == 1) PG8_BAR;
        PG8_WAIT_V(2); PG8_BAR;
        PG8_STAGE(PG8_SB(1, 0), cB + kstep, voffB); PG8_STAGE(PG8_SA(1, 0), cA + kstep, voffA); PG8_STAGE(PG8_SB(1, 1), cB + hstep + kstep, voffB);
        PG8_WAIT_V(6); PG8_BAR;
    } else {
        PG8_STAGE(PG8_SB(0, 0), cB, voffB); PG8_STAGE(PG8_SA(0, 0), cA, voffA); PG8_STAGE(PG8_SB(0, 1), cB + hstep, voffB); PG8_STAGE(PG8_SA(0, 1), cA + hstep, voffA);
        if (wr == 1) PG8_BAR;
        PG8_WAIT_V(4); PG8_BAR;
        PG8_STAGE(PG8_SB(1, 0), cB + kstep, voffB); PG8_STAGE(PG8_SA(1, 0), cA + kstep, voffA); PG8_STAGE(PG8_SB(1, 1), cB + hstep + kstep, voffB);
        PG8_WAIT_V(6); PG8_BAR;
    }
    for (;;) {
        const bool has_next = S.next(ui + 1, nxt);
        const char* nA = has_next ? (const char*)g.A + (size_t)nxt.pm * tstep : cA; const char* nB = has_next ? (const char*)g.Bt + (size_t)nxt.pn * tstep : cB;
        for (int t = 0; t < nt; t += 2) {
            const bool last = (t == nt - 2);
            const char* a1 = cA + (size_t)(t + 1) * kstep;
            const char* a2 = last ? nA : cA + (size_t)(t + 2) * kstep; const char* b2 = last ? nB : cB + (size_t)(t + 2) * kstep;
            const char* a3 = a2 + kstep; const char* b3 = b2 + kstep;
            if (last && has_next) S.a_ready(nxt);
            if constexpr (SP2) {
            PG8_LDB(B0, 0, 0); PG8_LDB(B1, 0, 1); PG8_SCHED; PG8_LDA(At, 0, 0); PG8_STAGE(PG8_SA(1, 1), a1 + hstep, voffA);
            PG8_WAIT_V(8); PG8_WAIT_L(0); PG8_BAR; PG8_MMA(0, 0, At, B0); PG8_MMA(0, 1, At, B1); PG8_BAR; PG8_SCHED;
            PG8_LDA(At, 0, 1); PG8_STAGE(PG8_SB(0, 0), b2, voffB); PG8_STAGE(PG8_SB(0, 1), b2 + hstep, voffB); PG8_STAGE(PG8_SA(0, 0), a2, voffA);
            PG8_WAIT_V(8); PG8_WAIT_L(0); PG8_BAR; PG8_MMA(1, 0, At, B0); PG8_MMA(1, 1, At, B1); PG8_BAR; PG8_SCHED;
            PG8_LDB(B0, 1, 0); PG8_LDB(B1, 1, 1); PG8_SCHED; PG8_LDA(At, 1, 0); PG8_STAGE(PG8_SA(0, 1), a2 + hstep, voffA);
            PG8_WAIT_V(8); PG8_WAIT_L(0); PG8_BAR; PG8_MMA(0, 0, At, B0); PG8_MMA(0, 1, At, B1); PG8_BAR; PG8_SCHED;
            PG8_LDA(At, 1, 1); PG8_STAGE(PG8_SB(1, 0), b3, voffB); PG8_STAGE(PG8_SB(1, 1), b3 + hstep, voffB); PG8_STAGE(PG8_SA(1, 0), a3, voffA);
            PG8_WAIT_V(8); PG8_WAIT_L(0); PG8_BAR; PG8_MMA(1, 0, At, B0); PG8_MMA(1, 1, At, B1); PG8_BAR; PG8_SCHED;
            } else {
            PG8_LDB(B0, 0, 0); PG8_SCHED; PG8_LDA(At, 0, 0); PG8_STAGE(PG8_SA(1, 1), a1 + hstep, voffA);
            PG8_WAIT_L(8); PG8_BAR; PG8_WAIT_L(0); PG8_MMA(0, 0, At, B0); PG8_BAR; PG8_SCHED;
            PG8_LDB(B1, 0, 1); PG8_STAGE(PG8_SB(0, 0), b2, voffB);
            PG8_BAR; PG8_WAIT_L(0); PG8_MMA(0, 1, At, B1); PG8_BAR;
            PG8_LDA(At, 0, 1); PG8_STAGE(PG8_SA(0, 0), a2, voffA);
            PG8_BAR; PG8_WAIT_L(0); PG8_MMA(1, 0, At, B0); PG8_BAR; PG8_SCHED;
            PG8_STAGE(PG8_SB(0, 1), b2 + hstep, voffB);
            PG8_WAIT_V(6); PG8_BAR; PG8_MMA(1, 1, At, B1); PG8_BAR;
            PG8_LDB(B0, 1, 0); PG8_SCHED; PG8_LDA(At, 1, 0); PG8_STAGE(PG8_SA(0, 1), a2 + hstep, voffA);
            PG8_WAIT_L(8); PG8_BAR; PG8_WAIT_L(0); PG8_MMA(0, 0, At, B0); PG8_BAR; PG8_SCHED;
            PG8_LDB(B1, 1, 1); PG8_STAGE(PG8_SB(1, 0), b3, voffB);
            PG8_BAR; PG8_WAIT_L(0); PG8_MMA(0, 1, At, B1); PG8_BAR;
            PG8_LDA(At, 1, 1); PG8_STAGE(PG8_SA(1, 0), a3, voffA);
            PG8_BAR; PG8_WAIT_L(0); PG8_MMA(1, 0, At, B0); PG8_BAR; PG8_SCHED;
            PG8_STAGE(PG8_SB(1, 1), b3 + hstep, voffB);
            PG8_WAIT_V(6); PG8_BAR; PG8_MMA(1, 1, At, B1); PG8_BAR;
            }
        }
        if constexpr (ALIGN_EPI) { if (wr == 0) PG8_BAR; }
        if constexpr (!Epi::AFTER_DRAIN) { E(acc, cur, wr, wc, fr, fq); S.done(cur); }
        if (!has_next) break;
#pragma unroll
        for (int a = 0; a < 2; ++a)
#pragma unroll
            for (int b = 0; b < 2; ++b)
#pragma unroll
                for (int m = 0; m < 4; ++m)
#pragma unroll
                    for (int n = 0; n < 2; ++n) acc[a][b][m][n] = (f32x4){0.f, 0.f, 0.f, 0.f};
        cur = nxt; cA = nA; cB = nB; ++ui;
        if constexpr (ALIGN_EPI) { if (wr == 1) PG8_BAR; }
    }
    PG8_WAIT_V(0);
    if constexpr (!ALIGN_EPI) { if (wr == 0) PG8_BAR; }
    PG8_BAR;
    if constexpr (Epi::AFTER_DRAIN) { E.fused(acc, cur, wr, wc, fr, fq, lds, wid, lane); S.done(cur); }
#undef PG8_SA
#undef PG8_SB
#undef PG8_STAGE
#undef PG8_LDA
#undef PG8_LDB
#undef PG8_MMA
#undef PG8_WAIT_V
#undef PG8_WAIT_L
#undef PG8_BAR
#undef PG8_SCHED
}
}

typedef unsigned short u16;
using pg8::bf16x8; using pg8::f32x4; using pg8::u32x4;
typedef short s16x4 __attribute__((ext_vector_type(4)));
typedef float f32x16 __attribute__((ext_vector_type(16)));
typedef unsigned u32x2 __attribute__((ext_vector_type(2)));

constexpr int DM = 1024, TSEQ = 8192, NSEQ = 12, NT = NSEQ * TSEQ, DEPTH_ = 2;
constexpr int DFF = 2816, NGU = 2 * DFF, NIN = 3456, NINP = 3584, RWC = 1920, DAC = 1536;
constexpr float ALPHA_ = 1.4142135623730951f;
constexpr float LN_EPS_ = 1e-5f, GN_EPS_ = 64e-5f, SUBLN_EPS_ = 1e-5f;
constexpr int LDS_BYTES = 163840;

constexpr size_t WS_WGU = 0;
constexpr size_t WS_WDN = WS_WGU + (size_t)2 * 2 * NGU * DM * 2;
constexpr size_t WS_WIN = WS_WDN + (size_t)2 * 2 * DM * DFF * 2;
constexpr size_t WS_WOUT = WS_WIN + (size_t)2 * NINP * DM * 2;
constexpr size_t WS_WUP = WS_WOUT + (size_t)2 * DM * DM * 2;
constexpr size_t WS_AUP = WS_WUP + (size_t)2 * 2 * 512 * 64 * 2;
constexpr size_t WS_GUP = WS_AUP + (size_t)2 * 2 * 512 * 64 * 2;
constexpr size_t WS_ROPE = WS_GUP + (size_t)2 * 512 * 128 * 2;
constexpr size_t WS_RK = WS_ROPE + (size_t)TSEQ * 32 * 2 * 4;
constexpr size_t WS_SCR = WS_RK + (size_t)2 * NT * 8 * 4;
constexpr size_t WS_Q = WS_SCR + (size_t)256 * 256 * 128 * 4;
constexpr size_t WS_XB = WS_Q + (size_t)4096;
constexpr size_t WS_BIG = WS_XB + (size_t)NT * DM * 2;
constexpr size_t WS_PRW = WS_BIG;
constexpr size_t WS_PDA = WS_PRW + (size_t)NT * RWC * 2;
constexpr size_t WS_END = WS_PDA + (size_t)NT * DAC * 2;
static_assert(WS_BIG + (size_t)NT * DFF * 2 <= WS_END, "H fits");
static_assert(WS_END <= (size_t)1073741824, "workspace budget");

struct Params {
    const float* in[21];
    float* out;
    unsigned char* ws;
    float inv[32];
};

typedef const __attribute__((address_space(4))) Params* KP;
__device__ __forceinline__ KP launder_kp(KP p) { asm volatile("" : "+s"(p)); return p; }
__device__ __forceinline__ int otid() { int t = threadIdx.x; asm volatile("" : "+v"(t)); return t; }
__device__ __forceinline__ float bf2f(u16 b) { return __uint_as_float(((unsigned)b) << 16); }
__device__ __forceinline__ float bflo(unsigned w) { return __uint_as_float(w << 16); }
__device__ __forceinline__ float bfhi(unsigned w) { return __uint_as_float(w & 0xffff0000u); }
__device__ __forceinline__ unsigned cvtpk(float lo, float hi) { return pg8::cvt_pk_bf16(lo, hi); }
__device__ __forceinline__ u16 f2bf(float x) { return (u16)(cvtpk(x, 0.f) & 0xffffu); }
__device__ __forceinline__ void unpack8(const u32x4 w, float* f) {
    f[0] = bflo(w[0]); f[1] = bfhi(w[0]); f[2] = bflo(w[1]); f[3] = bfhi(w[1]); f[4] = bflo(w[2]); f[5] = bfhi(w[2]); f[6] = bflo(w[3]); f[7] = bfhi(w[3]);
}
__device__ __forceinline__ u32x4 pack8(const float* f) { u32x4 w = {cvtpk(f[0], f[1]), cvtpk(f[2], f[3]), cvtpk(f[4], f[5]), cvtpk(f[6], f[7])}; return w; }
__device__ __forceinline__ int crow(int r, int hi) { return (r & 3) + 8 * (r >> 2) + 4 * hi; }
__device__ __forceinline__ float sigmoidf_(float x) { return 1.f / (1.f + __expf(-x)); }

struct EpiSwiglu {
    static constexpr bool PERM = true, AFTER_DRAIN = false;
    u16* H;
    __device__ __forceinline__ void operator()(const f32x4 (&acc)[2][2][4][2], const pg8::Unit& u, int wr, int wc, int fr, int fq) const {
        const int row0 = u.pm * 256 + wr * 64 + fr, col0 = u.pn * 128 + wc * 32 + 8 * fq;
#pragma unroll
        for (int ai = 0; ai < 2; ++ai)
#pragma unroll
            for (int m = 0; m < 4; ++m) {
                float o[8];
#pragma unroll
                for (int n = 0; n < 2; ++n)
#pragma unroll
                    for (int e = 0; e < 4; ++e) { const float g = acc[ai][0][m][n][e], up = acc[ai][1][m][n][e]; o[n * 4 + e] = g * __builtin_amdgcn_rcpf(1.f + __builtin_amdgcn_exp2f(g * -1.4426950408889634f)) * up; }
                *(u32x4*)(H + (size_t)(row0 + ai * 128 + m * 16) * DFF + col0) = pack8(o);
            }
    }
};
struct EpiResid {
    static constexpr bool PERM = false, AFTER_DRAIN = false;
    float* X; float scale; const float* S0; const float* S1; const u16* SB;
    __device__ __forceinline__ void operator()(const f32x4 (&acc)[2][2][4][2], const pg8::Unit& u, int wr, int wc, int fr, int fq) const {
        const int row0 = u.pm * 256 + wr * 64 + fr, col0 = u.pn * 256 + wc * 32 + 4 * fq;
        const float* src = u.pm < 256 ? S0 : S1 - (size_t)65536 * DM * (S1 != X);
#pragma unroll
        for (int ai = 0; ai < 2; ++ai)
#pragma unroll
            for (int m = 0; m < 4; ++m) { const size_t ro = (size_t)(row0 + ai * 128 + m * 16) * DM + col0;
#pragma unroll
                for (int bj = 0; bj < 2; ++bj)
#pragma unroll
                    for (int n = 0; n < 2; ++n) { f32x4 x;
                        if (SB) { const u32x2 w = *(const u32x2*)(SB + ro + bj * 128 + n * 16); x = (f32x4){bflo(w[0]), bfhi(w[0]), bflo(w[1]), bfhi(w[1])}; }
                        else x = *(const f32x4*)(src + ro + bj * 128 + n * 16);
                        *(f32x4*)(X + ro + bj * 128 + n * 16) = x * ALPHA_ + acc[ai][bj][m][n] * scale; } }
    }
};
struct EpiProj {
    static constexpr bool PERM = true, AFTER_DRAIN = false;
    u16* PRW; u16* PDA; const float* rt;
    __device__ __forceinline__ void operator()(const f32x4 (&acc)[2][2][4][2], const pg8::Unit& u, int wr, int wc, int fr, int fq) const {
        const int row0 = u.pm * 256 + wr * 64 + fr;
#pragma unroll
        for (int bj = 0; bj < 2; ++bj) {
            const int cb = u.pn * 256 + bj * 128;
            if (cb >= RWC && cb < RWC + 1024) {
                const int i4 = 4 * (4 * (wc & 1) + fq);
                u16* vb = PDA + (cb - RWC) + 64 * (wc >> 1) + i4;
#pragma unroll
                for (int ai = 0; ai < 2; ++ai)
#pragma unroll
                    for (int m = 0; m < 4; ++m) {
                        const int row = row0 + ai * 128 + m * 16, pos = row & (TSEQ - 1);
                        const f32x4 t0 = *(const f32x4*)(rt + (pos * 32 + i4) * 2), t1 = *(const f32x4*)(rt + (pos * 32 + i4) * 2 + 4);
                        const f32x4 x1 = acc[ai][bj][m][0], x2 = acc[ai][bj][m][1];
                        const f32x4 cs = {t0[0], t0[2], t1[0], t1[2]}, sn = {t0[1], t0[3], t1[1], t1[3]};
                        const f32x4 o1 = x1 * cs - x2 * sn, o2 = x2 * cs + x1 * sn;
                        u32x2 w1 = {cvtpk(o1[0], o1[1]), cvtpk(o1[2], o1[3])}, w2 = {cvtpk(o2[0], o2[1]), cvtpk(o2[2], o2[3])};
                        *(u32x2*)(vb + (size_t)row * DAC) = w1; *(u32x2*)(vb + (size_t)row * DAC + 32) = w2;
                    }
                continue;
            }
            u16* base; int ld;
            if (cb < RWC) { base = PRW + cb; ld = RWC; } else if (cb < NIN) { base = PDA + (cb - RWC); ld = DAC; } else continue;
            base += wc * 32 + 8 * fq;
#pragma unroll
            for (int ai = 0; ai < 2; ++ai)
#pragma unroll
                for (int m = 0; m < 4; ++m) {
                    float o[8];
#pragma unroll
                    for (int n = 0; n < 2; ++n)
#pragma unroll
                        for (int e = 0; e < 4; ++e) o[n * 4 + e] = acc[ai][bj][m][n][e];
                    *(u32x4*)(base + (size_t)(row0 + ai * 128 + m * 16) * ld) = pack8(o);
                }
        }
    }
};

template <class Epi>
__device__ __forceinline__ void run_gemm(unsigned char* shm, const u16* A, const u16* Bt, int N, int K, const Epi& E) {
    pg8::Gemm g; g.A = A; g.Bt = Bt; g.M = NT; g.N = N; g.K = K;
    pg8::StaticOrder S; S.init(NT, N, (int)gridDim.x, (int)blockIdx.x);
    pg8::gemm_phase<Epi, pg8::StaticOrder, true, true>((PG8_LAS unsigned char*)shm, g, S, E);
}

template <int MAP>
__device__ __forceinline__ void tr_job(const float* __restrict__ src, int K, int ld, u16* __restrict__ dst, int Ndst, float* tile) {
    const int tid = otid(), ntk = K / 64, ntn = Ndst / 64;
    for (int ti = blockIdx.x; ti < ntk * ntn; ti += gridDim.x) {
        const int tn = ti / ntk, tk = ti % ntk, n0 = tn * 64, k0 = tk * 64;
        int sc0 = n0; bool zero = false;
        if (MAP == 1) { const int pn = n0 >> 8, bj = (n0 >> 7) & 1, c = n0 & 127; sc0 = bj * DFF + pn * 128 + c; }
        if (MAP == 2) zero = n0 >= NIN;
        const int c4 = (tid & 15) * 4;
#pragma unroll
        for (int p = 0; p < 2; ++p) { const int kr = (tid >> 4) + p * 32;
            f32x4 v = {0.f, 0.f, 0.f, 0.f}; if (!zero) v = *(const f32x4*)(src + (size_t)(k0 + kr) * ld + sc0 + c4);
            tile[kr * 65 + c4 + 0] = v[0]; tile[kr * 65 + c4 + 1] = v[1]; tile[kr * 65 + c4 + 2] = v[2]; tile[kr * 65 + c4 + 3] = v[3]; }
        __syncthreads();
        { const int nr = tid >> 3, kc = (tid & 7) * 8; float f[8];
          const int nrs = (MAP == 2 && n0 >= RWC && n0 < RWC + 1024) ? (((nr & 7) < 4) ? 4 * (nr >> 3) + (nr & 7) : 32 + 4 * (nr >> 3) + (nr & 7) - 4) : nr;
#pragma unroll
          for (int e = 0; e < 8; ++e) f[e] = tile[(kc + e) * 65 + nrs];
          *(u32x4*)(dst + (size_t)(n0 + nr) * K + k0 + kc) = pack8(f); }
        __syncthreads();
    }
}

__device__ __forceinline__ void phase0(KP P, unsigned char* shm) {
    float* tile = (float*)shm; unsigned char* ws = P->ws;
    for (int i = 0; i < 4; ++i) {
        tr_job<1>(P->in[4] + (size_t)i * DM * NGU, DM, NGU, (u16*)(ws + WS_WGU) + (size_t)i * NGU * DM, NGU, tile);
        tr_job<0>(P->in[5] + (size_t)i * DFF * DM, DFF, DM, (u16*)(ws + WS_WDN) + (size_t)i * DM * DFF, DM, tile);
        tr_job<0>(P->in[9] + (size_t)i * 64 * 512, 64, 512, (u16*)(ws + WS_WUP) + (size_t)i * 512 * 64, 512, tile);
        tr_job<0>(P->in[11] + (size_t)i * 64 * 512, 64, 512, (u16*)(ws + WS_AUP) + (size_t)i * 512 * 64, 512, tile);
    }
    for (int l = 0; l < 2; ++l) {
        tr_job<2>(P->in[6] + (size_t)l * DM * NIN, DM, NIN, (u16*)(ws + WS_WIN) + (size_t)l * NINP * DM, NINP, tile);
        tr_job<0>(P->in[7] + (size_t)l * DM * DM, DM, DM, (u16*)(ws + WS_WOUT) + (size_t)l * DM * DM, DM, tile);
        tr_job<0>(P->in[13] + (size_t)l * 128 * 512, 128, 512, (u16*)(ws + WS_GUP) + (size_t)l * 512 * 128, 512, tile);
    }
    const size_t gt = (size_t)blockIdx.x * 512 + otid(), gn = (size_t)gridDim.x * 512;
    { unsigned* qz = (unsigned*)(ws + WS_Q); for (size_t i = gt; i < 1024; i += gn) qz[i] = 0u; }
    { const size_t n4 = (size_t)NT * DM / 4, np4 = (size_t)8 * TSEQ * DM / 4;
      const f32x4* xp = (const f32x4*)P->in[0]; const f32x4* xs = (const f32x4*)P->in[1]; u32x2* xb = (u32x2*)(ws + WS_XB);
      for (size_t i = gt; i < n4; i += gn) { const f32x4 v = i < np4 ? xp[i] : xs[i - np4]; u32x2 w = {cvtpk(v[0], v[1]), cvtpk(v[2], v[3])}; xb[i] = w; } }
    { float* rt = (float*)(ws + WS_ROPE);
      for (size_t idx = gt; idx < (size_t)TSEQ * 32; idx += gn) {
          const int t = (int)(idx >> 5), i = (int)(idx & 31);
          const float angf = (float)t * P->inv[i];
          const double x = (double)angf, n = rint(x * 0.63661977236758134308), r = fma(-n, 6.123233995736766e-17, fma(-n, 1.5707963267948966, x));
          const int q = ((int)n) & 3; const double r2 = r * r;
          double sn = r2 * (1.0 / 6227020800.0) - (1.0 / 39916800.0); sn = sn * r2 + (1.0 / 362880.0); sn = sn * r2 - (1.0 / 5040.0); sn = sn * r2 + (1.0 / 120.0); sn = sn * r2 - (1.0 / 6.0); sn = sn * r2 * r + r;
          double cs = r2 * (-1.0 / 87178291200.0) + (1.0 / 479001600.0); cs = cs * r2 - (1.0 / 3628800.0); cs = cs * r2 + (1.0 / 40320.0); cs = cs * r2 - (1.0 / 720.0); cs = cs * r2 + (1.0 / 24.0); cs = cs * r2 - 0.5; cs = cs * r2 + 1.0;
          double s_, c_; if (q == 0) { s_ = sn; c_ = cs; } else if (q == 1) { s_ = cs; c_ = -sn; } else if (q == 2) { s_ = -sn; c_ = -cs; } else { s_ = -cs; c_ = sn; }
          rt[idx * 2 + 0] = (float)c_; rt[idx * 2 + 1] = (float)s_;
      } }
}

__device__ __forceinline__ float wave_sum(float x) {
#pragma unroll
    for (int o = 32; o >= 1; o >>= 1) x += __shfl_xor(x, o);
    return x;
}
template <int MODE>
__device__ __forceinline__ void ln_phase(float* X, u16* Xb, const float* __restrict__ g, const float* __restrict__ b) {
    const int tid_ = otid(), wid = tid_ >> 6, lane = tid_ & 63;
    f32x4 gv[4], bv[4];
#pragma unroll
    for (int j = 0; j < 4; ++j) { gv[j] = *(const f32x4*)(g + j * 256 + lane * 4); bv[j] = *(const f32x4*)(b + j * 256 + lane * 4); }
    for (int row = blockIdx.x * 8 + wid; row < NT; row += gridDim.x * 8) {
        float* xr = X + (size_t)row * DM; f32x4 v[4]; float s = 0.f;
#pragma unroll
        for (int j = 0; j < 4; ++j) { v[j] = *(const f32x4*)(xr + j * 256 + lane * 4); s += v[j][0] + v[j][1] + v[j][2] + v[j][3]; }
        const float mu = wave_sum(s) * (1.f / DM); float q = 0.f;
#pragma unroll
        for (int j = 0; j < 4; ++j) { v[j] = v[j] - mu; q += v[j][0] * v[j][0] + v[j][1] * v[j][1] + v[j][2] * v[j][2] + v[j][3] * v[j][3]; }
        const float rs = 1.0f / sqrtf(wave_sum(q) * (1.f / DM) + LN_EPS_);
#pragma unroll
        for (int j = 0; j < 4; ++j) { const f32x4 y = v[j] * rs * gv[j] + bv[j];
            if (MODE != 1) *(f32x4*)(xr + j * 256 + lane * 4) = y;
            if (MODE != 2) { u32x2 w = {cvtpk(y[0], y[1]), cvtpk(y[2], y[3])}; *(u32x2*)(Xb + (size_t)row * DM + j * 256 + lane * 4) = w; } }
    }
}

__device__ __forceinline__ void rope_phase(u16* PDA, const float* __restrict__ rt) {
    const size_t total = (size_t)NT * 64;
    for (size_t i = (size_t)blockIdx.x * 512 + otid(); i < total; i += (size_t)gridDim.x * 512) {
        const int token = (int)(i >> 6), sub = (int)(i & 63), vec = sub >> 2, f0 = (sub & 3) * 8, pos = token & (TSEQ - 1);
        u16* p = PDA + (size_t)token * DAC + vec * 64 + f0;
        const u32x4 w1 = *(const u32x4*)p, w2 = *(const u32x4*)(p + 32);
        float x1[8], x2[8], o1[8], o2[8]; unpack8(w1, x1); unpack8(w2, x2);
        const float* cs = rt + ((size_t)pos * 32 + f0) * 2;
#pragma unroll
        for (int e = 0; e < 8; ++e) { const float c = cs[2 * e], s = cs[2 * e + 1]; o1[e] = x1[e] * c - x2[e] * s; o2[e] = x2[e] * c + x1[e] * s; }
        *(u32x4*)p = pack8(o1); *(u32x4*)(p + 32) = pack8(o2);
    }
}

namespace att {
constexpr int NW = 8, QBLK = 32, KVBLK = 64, LDQ = DAC;
constexpr float SCALE = 0.125f, THR = 8.f;
constexpr int SHM_V = KVBLK * 128 * 2, SHM_K = KVBLK * 64 * 2;
#define KSWZ(row, colB) ((row) * 128 + ((colB) ^ ((((row) >> 1) & 7) << 4)))
#define SBAR() __builtin_amdgcn_sched_barrier(0)
__device__ __forceinline__ void partialSM(f32x16& p0, f32x16& p1, float& m_reg, float& mn, float& alpha) {
    constexpr float C = SCALE * 1.4426950408889634f;
    float pmax = p0[0];
#pragma unroll
    for (int r = 1; r < 16; ++r) pmax = fmaxf(pmax, p0[r]);
#pragma unroll
    for (int r = 0; r < 16; ++r) pmax = fmaxf(pmax, p1[r]);
    { auto rr = __builtin_amdgcn_permlane32_swap(__float_as_uint(pmax), __float_as_uint(pmax), false, false);
      pmax = fmaxf(__uint_as_float(rr[0]), __uint_as_float(rr[1])); }
    if (__builtin_expect(__all(pmax - m_reg <= THR / SCALE), 1)) { mn = m_reg; alpha = 1.f; }
    else { mn = fmaxf(m_reg, pmax); alpha = __builtin_amdgcn_exp2f((m_reg - mn) * C); m_reg = mn; }
    const float mnC = -mn * C;
#pragma unroll
    for (int r = 0; r < 16; ++r) p0[r] = fmaf(p0[r], C, mnC);
#pragma unroll
    for (int r = 0; r < 16; ++r) p1[r] = fmaf(p1[r], C, mnC);
#pragma unroll
    for (int r = 0; r < 16; ++r) p0[r] = __builtin_amdgcn_exp2f(p0[r]);
}
__device__ __forceinline__ void finishSM(f32x16& p0, f32x16& p1, float alpha, float& l_reg, bf16x8& pa0, bf16x8& pa1, bf16x8& pa2, bf16x8& pa3) {
#pragma unroll
    for (int r = 0; r < 16; ++r) p1[r] = __builtin_amdgcn_exp2f(p1[r]);
    float ps = 0;
#pragma unroll
    for (int r = 0; r < 16; ++r) ps += p0[r];
#pragma unroll
    for (int r = 0; r < 16; ++r) ps += p1[r];
    { auto rr = __builtin_amdgcn_permlane32_swap(__float_as_uint(ps), __float_as_uint(ps), false, false);
      ps = __uint_as_float(rr[0]) + __uint_as_float(rr[1]); }
    l_reg = l_reg * alpha + ps;
#define PK4(P, BASE, OUT) do { unsigned a0 = cvtpk(P[BASE + 0], P[BASE + 1]), a1 = cvtpk(P[BASE + 2], P[BASE + 3]);   \
    unsigned b0 = cvtpk(P[BASE + 4], P[BASE + 5]), b1 = cvtpk(P[BASE + 6], P[BASE + 7]);                              \
    auto r0 = __builtin_amdgcn_permlane32_swap(a0, b0, false, false); auto r1 = __builtin_amdgcn_permlane32_swap(a1, b1, false, false); \
    u32x4 w = {r0[0], r1[0], r0[1], r1[1]}; OUT = *reinterpret_cast<bf16x8*>(&w); } while (0)
    PK4(p0, 0, pa0); PK4(p0, 8, pa1); PK4(p1, 0, pa2); PK4(p1, 8, pa3);
#undef PK4
}
__device__ __forceinline__ void qkt(f32x16& p0, f32x16& p1, const char* Ks, const bf16x8* qr, int r32, int hi) {
    p0 = f32x16{}; p1 = f32x16{};
#pragma unroll
    for (int d0 = 0; d0 < 4; ++d0) { const int cb = (d0 * 16 + hi * 8) * 2;
        const bf16x8 b0 = *reinterpret_cast<const bf16x8*>(Ks + KSWZ(r32, cb));
        const bf16x8 b1 = *reinterpret_cast<const bf16x8*>(Ks + KSWZ(32 + r32, cb));
        p0 = __builtin_amdgcn_mfma_f32_32x32x16_bf16(b0, qr[d0], p0, 0, 0, 0);
        p1 = __builtin_amdgcn_mfma_f32_32x32x16_bf16(b1, qr[d0], p1, 0, 0, 0); }
}
__device__ __forceinline__ int v_st(int k, int c) { const int kk = (k & ~0xC) | ((k & 4) << 1) | ((k & 8) >> 1); return ((kk >> 3) * 4 + (c >> 5)) * 512 + ((kk & 7) * 32 + (c & 31)) * 2; }
__device__ __forceinline__ int v_rd_base(int lane) { return ((lane & 3) << 3) | (((lane >> 2) & 3) << 6) | (((lane >> 4) & 1) << 5) | (((lane >> 5) & 1) << 8); }
constexpr int v_rd_off(int d0, int ks, int half) { return d0 * 512 + ks * 4096 + half * 2048; }
template <int OFF> __device__ __forceinline__ s16x4 tr_read(int vb) {
    s16x4 r; asm volatile("ds_read_b64_tr_b16 %0, %1 offset:%2" : "=&v"(r) : "v"(vb), "i"(OFF) : "memory"); return r;
}
template <int D0> __device__ __forceinline__ void pv_one(f32x16& od, int vb, bf16x8 pa0, bf16x8 pa1, bf16x8 pa2, bf16x8 pa3) {
    const s16x4 l0 = tr_read<v_rd_off(D0, 0, 0)>(vb), h0 = tr_read<v_rd_off(D0, 0, 1)>(vb), l1 = tr_read<v_rd_off(D0, 1, 0)>(vb), h1 = tr_read<v_rd_off(D0, 1, 1)>(vb);
    const s16x4 l2 = tr_read<v_rd_off(D0, 2, 0)>(vb), h2 = tr_read<v_rd_off(D0, 2, 1)>(vb), l3 = tr_read<v_rd_off(D0, 3, 0)>(vb), h3 = tr_read<v_rd_off(D0, 3, 1)>(vb);
    asm volatile("s_waitcnt lgkmcnt(0)" ::: "memory"); SBAR();
#define PK(L, H) (bf16x8){L[0], L[1], L[2], L[3], H[0], H[1], H[2], H[3]}
    od = __builtin_amdgcn_mfma_f32_32x32x16_bf16(pa0, PK(l0, h0), od, 0, 0, 0);
    od = __builtin_amdgcn_mfma_f32_32x32x16_bf16(pa1, PK(l1, h1), od, 0, 0, 0);
    od = __builtin_amdgcn_mfma_f32_32x32x16_bf16(pa2, PK(l2, h2), od, 0, 0, 0);
    od = __builtin_amdgcn_mfma_f32_32x32x16_bf16(pa3, PK(l3, h3), od, 0, 0, 0);
#undef PK
}
__device__ __forceinline__ void pv_d0(f32x16* o, int vb, bf16x8 pa0, bf16x8 pa1, bf16x8 pa2, bf16x8 pa3) {
    pv_one<0>(o[0], vb, pa0, pa1, pa2, pa3); pv_one<1>(o[1], vb, pa0, pa1, pa2, pa3); pv_one<2>(o[2], vb, pa0, pa1, pa2, pa3); pv_one<3>(o[3], vb, pa0, pa1, pa2, pa3);
}

__device__ __forceinline__ void attn_pass(const u16* __restrict__ Qb, const u16* __restrict__ Kh, const u16* __restrict__ Vh, char* lds, f32x16* o, float& l_out) {
    const int tid = otid(), wid = tid >> 6, lane = tid & 63, r32 = lane & 31, hi = lane >> 5, cp = wid >> 2, wq = wid & 3;
    constexpr int SLOT = SHM_V + 2 * SHM_K;
    float* wsl = (float*)(lds + 3 * SLOT) + wid * 64; float* al_l = wsl + 32;
    float m_reg = -1e30f, l_reg = 0;
#pragma unroll
    for (int d = 0; d < 4; ++d) o[d] = f32x16{};
    bf16x8 qr[4];
    const u16* Qw = Qb + (size_t)(wq * QBLK + r32) * LDQ + cp * 64 + hi * 8;
#pragma unroll
    for (int d0 = 0; d0 < 4; ++d0) qr[d0] = *reinterpret_cast<const bf16x8*>(Qw + d0 * 16);
    const int sr = tid >> 4, sc = (tid & 15) * 8, vst0 = v_st(sr, sc), vst1 = v_st(32 + sr, sc);
    const int kr = tid >> 3, kcB = (tid & 7) * 16, kst = SHM_V + KSWZ(kr, kcB);
    const int vbl = (int)(uintptr_t)lds + v_rd_base(lane);
    struct { bf16x8 vs0, vs1, ks0, ks1; } sr_[2];
    const char* Kl = lds + SHM_V + cp * SHM_K;
#define SLOAD(i, k0) do { sr_[i].vs0 = *reinterpret_cast<const bf16x8*>(&Vh[(size_t)((k0) + sr) * LDQ + sc]); sr_[i].vs1 = *reinterpret_cast<const bf16x8*>(&Vh[(size_t)((k0) + 32 + sr) * LDQ + sc]); \
    sr_[i].ks0 = *reinterpret_cast<const bf16x8*>(&Kh[(size_t)((k0) + kr) * LDQ + (tid & 7) * 8]); sr_[i].ks1 = *reinterpret_cast<const bf16x8*>(&Kh[(size_t)((k0) + kr) * LDQ + 64 + (tid & 7) * 8]); } while (0)
#define SWRITE(so, i) do { char* sb_ = lds + (so); *(bf16x8*)(sb_ + vst0) = sr_[i].vs0; *(bf16x8*)(sb_ + vst1) = sr_[i].vs1; \
    *(bf16x8*)(sb_ + kst) = sr_[i].ks0; *(bf16x8*)(sb_ + SHM_K + kst) = sr_[i].ks1; } while (0)
#define SWAIT() asm volatile("s_waitcnt vmcnt(4)" ::: "memory")
#define RESC(a) do { if (__any((a) < 1.f)) { if (hi == 0) al_l[r32] = (a); asm volatile("s_waitcnt lgkmcnt(0)" ::: "memory"); \
    _Pragma("unroll") for (int d = 0; d < 4; ++d) _Pragma("unroll") for (int r = 0; r < 16; ++r) o[d][r] *= al_l[crow(r, hi)]; } } while (0)
#define ROT() do { const int t_ = rp; rp = rc; rc = rn; rn = t_; } while (0)
    f32x16 pA0, pA1, pB0, pB1; float mnA, mnB, alA, alB; bf16x8 pa0, pa1, pa2, pa3; constexpr int NTL = TSEQ / KVBLK;
    constexpr int SE = 0, SO = 1;
    asm volatile("s_waitcnt vmcnt(0)" ::: "memory");
    SLOAD(SE, 0); asm volatile("s_waitcnt vmcnt(0)" ::: "memory"); SWRITE(0, SE); __syncthreads();
    qkt(pA0, pA1, Kl, qr, r32, hi); partialSM(pA0, pA1, m_reg, mnA, alA);
    SLOAD(SO, KVBLK); SLOAD(SE, 2 * KVBLK);
    SWAIT(); SWRITE(SLOT, SO); __syncthreads();
    int rp = 0, rc = SLOT, rn = 2 * SLOT;
    for (int j = 1; j + 1 < NTL; j += 2) {
        SBAR(); qkt(pB0, pB1, Kl + rc, qr, r32, hi);
        finishSM(pA0, pA1, alA, l_reg, pa0, pa1, pa2, pa3); SBAR();
        SLOAD(SO, (j + 2) * KVBLK); SBAR();
        pv_d0(o, vbl + rp, pa0, pa1, pa2, pa3); partialSM(pB0, pB1, m_reg, mnB, alB);
        SWAIT(); SWRITE(rn, SE);
        RESC(alB); __syncthreads(); ROT();
        SBAR(); qkt(pA0, pA1, Kl + rc, qr, r32, hi);
        finishSM(pB0, pB1, alB, l_reg, pa0, pa1, pa2, pa3); SBAR();
        if (j + 3 < NTL) SLOAD(SE, (j + 3) * KVBLK); SBAR();
        pv_d0(o, vbl + rp, pa0, pa1, pa2, pa3); partialSM(pA0, pA1, m_reg, mnA, alA);
        SWAIT(); SWRITE(rn, SO);
        RESC(alA); __syncthreads(); ROT();
    }
    SBAR(); qkt(pB0, pB1, Kl + rc, qr, r32, hi);
    finishSM(pA0, pA1, alA, l_reg, pa0, pa1, pa2, pa3); SBAR();
    pv_d0(o, vbl + rp, pa0, pa1, pa2, pa3); partialSM(pB0, pB1, m_reg, mnB, alB);
    RESC(alB);
    finishSM(pB0, pB1, alB, l_reg, pa0, pa1, pa2, pa3); SBAR();
    pv_d0(o, vbl + rc, pa0, pa1, pa2, pa3);
    l_out = l_reg;
#undef SLOAD
#undef SWRITE
#undef SWAIT
#undef RESC
#undef ROT
}
}

__device__ __forceinline__ void attn_phase(KP P, int l, unsigned char* shm) {
    const int tid = otid(), wid = tid >> 6, lane = tid & 63, r32 = lane & 31, hi = lane >> 5, cp = wid >> 2, wq = wid & 3;
    const u16* PDA = (const u16*)(P->ws + WS_PDA); u16* PDAw = (u16*)(P->ws + WS_PDA);
    float* li_l = (float*)(shm + 3 * (att::SHM_V + 2 * att::SHM_K)) + wid * 64;
    float* XCH = (float*)shm;
    const float lam_init = 0.8f - 0.6f * expf(-0.3f * (float)l);
    float lam;
    { const float* dl = P->in[19] + l * 256; const float p1 = wave_sum(dl[lane] * dl[64 + lane]), p2 = wave_sum(dl[128 + lane] * dl[192 + lane]); lam = expf(p1) - expf(p2) + lam_init; }
    float sg[4];
#pragma unroll
    for (int d0 = 0; d0 < 4; ++d0) sg[d0] = P->in[20][l * 128 + d0 * 32 + r32] * (1.f - lam_init);
    unsigned* qhead = (unsigned*)(P->ws + WS_Q) + l * 128;
    volatile int* slot = (volatile int*)(shm + 3 * (att::SHM_V + 2 * att::SHM_K) + 2048 + 64);
    const unsigned xcc = ((unsigned)__builtin_amdgcn_s_getreg((3 << 11) | 20)) & 7u;
    for (;;) {
        __syncthreads();
        if (tid == 0) { int item = -1;
            for (unsigned k = 0; k < 8u; ++k) { const unsigned qx = (xcc + k) & 7u; const unsigned idx = __hip_atomic_fetch_add(qhead + qx * 16, 1u, __ATOMIC_RELAXED, __HIP_MEMORY_SCOPE_AGENT);
                if (idx < 384u) { item = (int)(qx * 384u + idx); break; } }
            *slot = item; }
        __syncthreads();
        const int item = *slot; if (item < 0) break;
        const int qx = item / 384, idx = item - qx * 384;
        const int bh = (idx >> 6) * 8 + qx, qb = idx & 63, b = bh >> 2, h = bh & 3;
        const size_t tok0 = (size_t)b * TSEQ;
        f32x16 o[4]; float l_reg; float rli[16];
        __syncthreads();
        att::attn_pass(PDA + (tok0 + qb * 128) * DAC + h * 128, PDA + tok0 * DAC + 512 + h * 128, PDA + tok0 * DAC + 1024 + h * 128, (char*)shm, o, l_reg);
        asm volatile("s_waitcnt lgkmcnt(0)" ::: "memory");
        if (hi == 0) li_l[r32] = l_reg; asm volatile("s_waitcnt lgkmcnt(0)" ::: "memory");
#pragma unroll
        for (int r = 0; r < 16; ++r) rli[r] = 1.0f / li_l[crow(r, hi)];
        __syncthreads();
        if (cp == 1) {
#pragma unroll
            for (int r = 0; r < 16; ++r)
#pragma unroll
                for (int d0 = 0; d0 < 4; ++d0) XCH[((wq * 16 + r) * 4 + d0) * 64 + lane] = o[d0][r] * rli[r];
        }
        __syncthreads();
        if (cp == 0) {
            u16* yb = PDAw + (tok0 + qb * 128 + wq * 32 + 4 * hi) * DAC + h * 128 + r32; asm volatile("" : "+v"(yb));
#pragma unroll
            for (int r = 0; r < 16; ++r) {
                float v[4], ss = 0.f;
#pragma unroll
                for (int d0 = 0; d0 < 4; ++d0) { const float o1n = XCH[((wq * 16 + r) * 4 + d0) * 64 + lane];
                    v[d0] = o[d0][r] * rli[r] - lam * o1n; ss += v[d0] * v[d0]; }
#pragma unroll
                for (int m = 16; m >= 1; m >>= 1) ss += __shfl_xor(ss, m);
                const float rs = 1.0f / sqrtf(ss * (1.f / 128.f) + SUBLN_EPS_);
                u16* yr = yb + crow(r, 0) * DAC;
#pragma unroll
                for (int d0 = 0; d0 < 4; ++d0) yr[d0 * 32] = f2bf(v[d0] * rs * sg[d0]);
            }
        }
    }
}

__device__ __forceinline__ float allred4(float x) {
    { auto rr = __builtin_amdgcn_permlane16_swap(__float_as_uint(x), __float_as_uint(x), false, false); x = __uint_as_float(rr[0]) + __uint_as_float(rr[1]); }
    { auto rr = __builtin_amdgcn_permlane32_swap(__float_as_uint(x), __float_as_uint(x), false, false); x = __uint_as_float(rr[0]) + __uint_as_float(rr[1]); }
    return x;
}
#define DPPX(J) " row_newbcast:" #J " row_mask:0xf bank_mask:0xf\n"
#define SC_FMA(J) "v_fmac_f32_dpp %[acc0], %[x], %[s" #J "]" DPPX(J)
#define SC_FMB(J) "v_fmac_f32_dpp %[acc1], %[x], %[s" #J "]" DPPX(J)
#define SC_MUL(J) "v_mul_f32_dpp %[s" #J "], %[w], %[s" #J "]" DPPX(J)
#define SC_F1(J) "v_fmac_f32_dpp %[s" #J "], %[bb], %[sa]" DPPX(J)
#define SC_F2(J) "v_fmac_f32_dpp %[s" #J "], %[km], %[v]" DPPX(J)
#define SC_OA(J) "v_fmac_f32_dpp %[o0], %[r], %[s" #J "]" DPPX(J)
#define SC_OB(J) "v_fmac_f32_dpp %[o1], %[r], %[s" #J "]" DPPX(J)
#define ALL16(M) M(0) M(1) M(2) M(3) M(4) M(5) M(6) M(7) M(8) M(9) M(10) M(11) M(12) M(13) M(14) M(15)
#define EVEN8(M) M(0) M(2) M(4) M(6) M(8) M(10) M(12) M(14)
#define ODD8(M) M(1) M(3) M(5) M(7) M(9) M(11) M(13) M(15)
#define SIN_(J) [s##J] "v"(s##J),
#define SIO_(J) [s##J] "+v"(s##J),

__device__ __forceinline__ float fsig(float x) { return __builtin_amdgcn_rcpf(1.f + __expf(-x)); }
__device__ __forceinline__ void scan_load(int jn, int p, int lane, int b, int h, int d, const u16* __restrict__ PRW, u32x4 (&raw)[5][3]) {
    const int sl = lane >> 3, g_ = lane & 7, s = 8 * p + sl, tau = 32 * jn + s, t = d ? (TSEQ - 1 - tau) : tau; const size_t token = (size_t)b * TSEQ + t;
    const int cbase[5] = {64 * h, 512 + 64 * h, 1024 + 64 * h, 1536 + 64 * d, 1664 + 64 * d};
#pragma unroll
    for (int vec = 0; vec < 5; ++vec) {
        const u16* q = PRW + token * RWC + cbase[vec] + 8 * g_;
        raw[vec][0] = *(const u32x4*)q; raw[vec][1] = (u32x4){0u, 0u, 0u, 0u}; raw[vec][2] = (u32x4){0u, 0u, 0u, 0u};
        if (t > 0) raw[vec][1] = *(const u32x4*)(q - RWC); if (t < TSEQ - 1) raw[vec][2] = *(const u32x4*)(q + RWC);
    }
}
__device__ __forceinline__ void scan_produce(const u32x4 (&raw)[5][3], int jn, int p, int lane, int b, int h, int d, const u16* __restrict__ PRW, float* RK, unsigned char* ob, u16* WDXp, u16* ADXp,
                                             const float* MU_, const u16* Bw_, const u16* Ba_, const float (&bw)[4], const float (&ba)[4],
                                             const float* kkp_, const float* kap_, const float* rkp_) {
    float* R_ = (float*)ob; float* V_ = R_ + 2048; float* W_ = V_ + 2048; float* NKK_ = W_ + 2048; float* KM_ = NKK_ + 2048; float* BB_ = KM_ + 2048;
    const int sl = lane >> 3, g_ = lane & 7, s = 8 * p + sl, tau = 32 * jn + s, t = d ? (TSEQ - 1 - tau) : tau; const size_t token = (size_t)b * TSEQ + t;
    const int cbase[5] = {64 * h, 512 + 64 * h, 1024 + 64 * h, 1536 + 64 * d, 1664 + 64 * d};
    bf16x8 bfw[4][2], bfa[4][2];
    { const u16* Bw = Bw_; const u16* Ba = Ba_; asm volatile("" : "+v"(Bw), "+v"(Ba));
#pragma unroll
      for (int nb = 0; nb < 4; ++nb)
#pragma unroll
          for (int ks = 0; ks < 2; ++ks) { bfw[nb][ks] = *reinterpret_cast<const bf16x8*>(Bw + nb * 16 * 64 + 32 * ks); bfa[nb][ks] = *reinterpret_cast<const bf16x8*>(Ba + nb * 16 * 64 + 32 * ks); } }
#pragma unroll
    for (int vec = 0; vec < 5; ++vec) {
        float c[8], pv[8], nx[8], x[8]; unpack8(raw[vec][0], c); unpack8(raw[vec][1], pv); unpack8(raw[vec][2], nx);
#pragma unroll
        for (int e = 0; e < 8; ++e) { const float mp = MU_[vec * 128 + 8 * g_ + e], mn = MU_[vec * 128 + 64 + 8 * g_ + e]; x[e] = c[e] + mp * (pv[e] - c[e]) + mn * (nx[e] - c[e]); }
        if (vec < 3) { float* dst = (vec == 0 ? R_ : vec == 1 ? KM_ : V_) + s * 64 + 8 * g_;
            *(f32x4*)dst = (f32x4){x[0], x[1], x[2], x[3]}; *(f32x4*)(dst + 4) = (f32x4){x[4], x[5], x[6], x[7]}; }
        else { if (vec == 3) {
#pragma unroll
                for (int e = 0; e < 8; ++e) x[e] = 1.f - 2.f * __builtin_amdgcn_rcpf(1.f + __expf(2.f * x[e])); }
            *(u32x4*)((vec == 3 ? WDXp : ADXp) + sl * 72 + 8 * g_) = pack8(x); }
    }
    asm volatile("s_waitcnt lgkmcnt(0)" ::: "memory");
    { const int fr = lane & 15, fq = lane >> 4;
      bf16x8 aw[2], aa[2];
#pragma unroll
      for (int ks = 0; ks < 2; ++ks) { aw[ks] = *reinterpret_cast<const bf16x8*>(WDXp + fr * 72 + 32 * ks + 8 * fq); aa[ks] = *reinterpret_cast<const bf16x8*>(ADXp + fr * 72 + 32 * ks + 8 * fq); }
#pragma unroll
      for (int nb = 0; nb < 4; ++nb) {
          f32x4 cw = {0.f, 0.f, 0.f, 0.f}, ca = {0.f, 0.f, 0.f, 0.f};
#pragma unroll
          for (int ks = 0; ks < 2; ++ks) { cw = __builtin_amdgcn_mfma_f32_16x16x32_bf16(aw[ks], bfw[nb][ks], cw, 0, 0, 0); ca = __builtin_amdgcn_mfma_f32_16x16x32_bf16(aa[ks], bfa[nb][ks], ca, 0, 0, 0); }
          if (fq < 2) {
#pragma unroll
              for (int jj = 0; jj < 4; ++jj) { const int srow = 8 * p + 4 * fq + jj, n = 16 * nb + fr;
                  W_[srow * 64 + n] = __expf(-0.60653065971263342f * fsig(cw[jj] + bw[nb]));
                  BB_[srow * 64 + n] = fsig(ca[jj] + ba[nb]); } }
      } }
    asm volatile("s_waitcnt lgkmcnt(0)" ::: "memory");
    { float k[8], a[8], r[8], kkr[8], ss = 0.f, kkc[8], kac[8], rkc[8];
      { const float* kkp = kkp_; const float* kap = kap_; const float* rkp2 = rkp_; asm volatile("" : "+v"(kkp), "+v"(kap), "+v"(rkp2));
        const f32x4 q0 = *(const f32x4*)kkp, q1 = *(const f32x4*)(kkp + 4), q2 = *(const f32x4*)kap, q3 = *(const f32x4*)(kap + 4), q4 = *(const f32x4*)rkp2, q5 = *(const f32x4*)(rkp2 + 4);
#pragma unroll
        for (int e = 0; e < 4; ++e) { kkc[e] = q0[e]; kkc[4 + e] = q1[e]; kac[e] = q2[e]; kac[4 + e] = q3[e]; rkc[e] = q4[e]; rkc[4 + e] = q5[e]; } }
      { const f32x4 k0 = *(const f32x4*)(KM_ + s * 64 + 8 * g_), k1 = *(const f32x4*)(KM_ + s * 64 + 8 * g_ + 4), a0 = *(const f32x4*)(BB_ + s * 64 + 8 * g_), a1 = *(const f32x4*)(BB_ + s * 64 + 8 * g_ + 4),
                    r0 = *(const f32x4*)(R_ + s * 64 + 8 * g_), r1 = *(const f32x4*)(R_ + s * 64 + 8 * g_ + 4);
#pragma unroll
        for (int e = 0; e < 4; ++e) { k[e] = k0[e]; k[4 + e] = k1[e]; a[e] = a0[e]; a[4 + e] = a1[e]; r[e] = r0[e]; r[4 + e] = r1[e]; } }
#pragma unroll
      for (int e = 0; e < 8; ++e) { kkr[e] = k[e] * kkc[e]; ss += kkr[e] * kkr[e]; }
      ss += __shfl_xor(ss, 1); ss += __shfl_xor(ss, 2); ss += __shfl_xor(ss, 4);
      const float inv = __builtin_amdgcn_rsqf(fmaxf(ss, 1e-24f));
      float nk[8], bb[8], km[8], rkp = 0.f;
#pragma unroll
      for (int e = 0; e < 8; ++e) { const float kk = kkr[e] * inv; nk[e] = -kk; bb[e] = kk * a[e]; km[e] = k[e] * (1.f + (a[e] - 1.f) * kac[e]); rkp += r[e] * km[e] * rkc[e]; }
      rkp += __shfl_xor(rkp, 1); rkp += __shfl_xor(rkp, 2); rkp += __shfl_xor(rkp, 4);
      *(f32x4*)(NKK_ + s * 64 + 8 * g_) = (f32x4){nk[0], nk[1], nk[2], nk[3]}; *(f32x4*)(NKK_ + s * 64 + 8 * g_ + 4) = (f32x4){nk[4], nk[5], nk[6], nk[7]};
      *(f32x4*)(BB_ + s * 64 + 8 * g_) = (f32x4){bb[0], bb[1], bb[2], bb[3]}; *(f32x4*)(BB_ + s * 64 + 8 * g_ + 4) = (f32x4){bb[4], bb[5], bb[6], bb[7]};
      *(f32x4*)(KM_ + s * 64 + 8 * g_) = (f32x4){km[0], km[1], km[2], km[3]}; *(f32x4*)(KM_ + s * 64 + 8 * g_ + 4) = (f32x4){km[4], km[5], km[6], km[7]};
      if (g_ == 0) RK[((size_t)d * NT + token) * 8 + h] = rkp; }
}
__device__ __forceinline__ void scan_writeout(int jo, int p, int lane, int b, int h, int d, const float* O_, u16* OD) {
    const int sl = lane >> 3, g_ = lane & 7, s = 8 * p + sl, tau = 32 * jo + s, t = d ? (TSEQ - 1 - tau) : tau; const size_t token = (size_t)b * TSEQ + t;
    float f[8]; const f32x4 a0 = *(const f32x4*)(O_ + s * 64 + 8 * g_), a1 = *(const f32x4*)(O_ + s * 64 + 8 * g_ + 4);
#pragma unroll
    for (int e = 0; e < 4; ++e) { f[e] = a0[e]; f[4 + e] = a1[e]; }
    *(u32x4*)(OD + token * DM + d * 512 + 64 * h + 8 * g_) = pack8(f);
}

__device__ __forceinline__ void scan_phase(KP P, int l, unsigned char* shm) {
    const int tid = otid(), wid = tid >> 6, lane = tid & 63;
    constexpr int NCH = TSEQ / 32, OB_STRIDE = 49152, OO_BASE = 98304, PT_BASE = 114688, MU_BASE = 133120;
    float* MU_ = (float*)(shm + MU_BASE);
    const u16* PRW = (const u16*)(P->ws + WS_PRW); u16* OD = (u16*)(P->ws + WS_XB); float* RK = (float*)(P->ws + WS_RK);
    const int p = wid & 3; u16* WDXp = (u16*)(shm + PT_BASE + p * 4608); u16* ADXp = WDXp + 16 * 72;
    for (int u = blockIdx.x; u < 192; u += gridDim.x) {
        const int b = u >> 4, h = (u >> 1) & 7, d = u & 1;
        __syncthreads();
        for (int i = tid; i < 640; i += 512) { const int vec = i >> 7, which = (i >> 6) & 1, n = i & 63;
            const int cb = vec == 0 ? 64 * h : vec == 1 ? 512 + 64 * h : vec == 2 ? 1024 + 64 * h : vec == 3 ? 1536 + 64 * d : 1664 + 64 * d;
            MU_[i] = P->in[8][(size_t)(l * 2 + which) * RWC + cb + n]; }
        float bw[4], ba[4]; const u16* Bw; const u16* Ba; const float* kkp; const float* kap; const float* rkp;
        { const int fr = lane & 15, fq = lane >> 4, g_ = lane & 7;
          Bw = (const u16*)(P->ws + WS_WUP) + ((size_t)(l * 2 + d) * 512 + 64 * h + fr) * 64 + 8 * fq;
          Ba = (const u16*)(P->ws + WS_AUP) + ((size_t)(l * 2 + d) * 512 + 64 * h + fr) * 64 + 8 * fq;
#pragma unroll
          for (int nb = 0; nb < 4; ++nb) {
              bw[nb] = P->in[10][(size_t)(l * 2 + d) * 512 + 64 * h + 16 * nb + fr]; ba[nb] = P->in[12][(size_t)(l * 2 + d) * 512 + 64 * h + 16 * nb + fr]; }
          kkp = P->in[14] + l * 512 + 64 * h + 8 * g_; kap = P->in[15] + l * 512 + 64 * h + 8 * g_; rkp = P->in[16] + l * 512 + 64 * h + 8 * g_; }
        float s0 = 0, s1 = 0, s2 = 0, s3 = 0, s4 = 0, s5 = 0, s6 = 0, s7 = 0, s8 = 0, s9 = 0, s10 = 0, s11 = 0, s12 = 0, s13 = 0, s14 = 0, s15 = 0;
        __syncthreads();
        u32x4 raw[5][3];
        if (wid >= 4) { scan_load(0, p, lane, b, h, d, PRW, raw); scan_produce(raw, 0, p, lane, b, h, d, PRW, RK, shm, WDXp, ADXp, MU_, Bw, Ba, bw, ba, kkp, kap, rkp); scan_load(1, p, lane, b, h, d, PRW, raw); }
        __syncthreads();
        for (int j = 0; j < NCH; ++j) {
            unsigned char* ob = shm + (j & 1) * OB_STRIDE; float* O_ = (float*)(shm + OO_BASE + (j & 1) * 8192);
            if (wid < 4) {
                const float* R_ = (const float*)ob; const float* V_ = R_ + 2048; const float* W_ = V_ + 2048; const float* NKK_ = W_ + 2048; const float* KM_ = NKK_ + 2048; const float* BB_ = KM_ + 2048;
                float pn[4], pw[4], pb[4], pk[4], pr[4], pv[4];
#pragma unroll
                for (int i = 0; i < 4; ++i) { pn[i] = NKK_[i * 64 + lane]; pw[i] = W_[i * 64 + lane]; pb[i] = BB_[i * 64 + lane]; pk[i] = KM_[i * 64 + lane]; pr[i] = R_[i * 64 + lane]; pv[i] = V_[i * 64 + 16 * wid + (lane & 15)]; }
                for (int st = 0; st < 32; st += 4) {
#pragma unroll
                    for (int i = 0; i < 4; ++i) {
                        const float cn = pn[i], cw = pw[i], cb_ = pb[i], ck = pk[i], cr = pr[i], cv = pv[i];
                        { const int sn = st + 4 + i;
                          pn[i] = NKK_[sn * 64 + lane]; pw[i] = W_[sn * 64 + lane]; pb[i] = BB_[sn * 64 + lane]; pk[i] = KM_[sn * 64 + lane]; pr[i] = R_[sn * 64 + lane]; pv[i] = V_[sn * 64 + 16 * wid + (lane & 15)]; }
                        float sa0 = 0.f, sa1 = 0.f;
                        asm volatile("s_nop 1\n" EVEN8(SC_FMA) ODD8(SC_FMB) "s_nop 1\n"
                                     : [acc0] "+v"(sa0), [acc1] "+v"(sa1) : ALL16(SIN_) [x] "v"(cn));
                        const float sa = allred4(sa0 + sa1);
                        float o0 = 0.f, o1 = 0.f;
                        asm volatile("s_nop 1\n" ALL16(SC_MUL) ALL16(SC_F1) ALL16(SC_F2) EVEN8(SC_OA) ODD8(SC_OB) "s_nop 1\n"
                                     : ALL16(SIO_) [o0] "+v"(o0), [o1] "+v"(o1)
                                     : [sa] "v"(sa), [v] "v"(cv), [w] "v"(cw), [bb] "v"(cb_), [km] "v"(ck), [r] "v"(cr));
                        const float oo = allred4(o0 + o1);
                        O_[(st + i) * 64 + 16 * wid + (lane & 15)] = oo;
                    }
                }
            } else {
                if (j + 1 < NCH) scan_produce(raw, j + 1, p, lane, b, h, d, PRW, RK, shm + ((j + 1) & 1) * OB_STRIDE, WDXp, ADXp, MU_, Bw, Ba, bw, ba, kkp, kap, rkp);
                if (j + 2 < NCH) scan_load(j + 2, p, lane, b, h, d, PRW, raw);
                if (j >= 1) scan_writeout(j - 1, p, lane, b, h, d, (const float*)(shm + OO_BASE + ((j - 1) & 1) * 8192), OD);
            }
            __syncthreads();
        }
        if (wid >= 4) scan_writeout(NCH - 1, p, lane, b, h, d, (const float*)(shm + OO_BASE + ((NCH - 1) & 1) * 8192), OD);
    }
}

__device__ __forceinline__ float red32(float x) {
#pragma unroll
    for (int m = 16; m >= 1; m >>= 1) x += __shfl_xor(x, m);
    return x;
}
__device__ __forceinline__ void post_phase(KP P, int l, unsigned char* shm) {
    const int tid = otid(), wid = tid >> 6, lane = tid & 63, r32 = lane & 31, hi = lane >> 5, h = wid;
    u16* GS = (u16*)shm;
    float* G = (float*)(shm + 17408) + wid * (64 * 68);
    const u16* PRW = (const u16*)(P->ws + WS_PRW); const u16* PDA = (const u16*)(P->ws + WS_PDA); const float* RK = (const float*)(P->ws + WS_RK); u16* Y = (u16*)(P->ws + WS_XB);
    const u16* gup0 = (const u16*)(P->ws + WS_GUP) + ((size_t)l * 512 + 64 * h + r32) * 128 + 8 * hi;
    const int s_ = tid >> 3, g_ = tid & 7, ls = lane >> 3, lg = lane & 7;
    const float* mgp0 = P->in[8] + (size_t)(l * 2 + 0) * RWC + 1792 + 16 * g_;
    float gng[8], gnb[8], mvp[8], mvn[8];
#pragma unroll
    for (int e = 0; e < 8; ++e) { const int c = 64 * h + 8 * lg + e; gng[e] = P->in[17][l * 512 + c]; gnb[e] = P->in[18][l * 512 + c];
        mvp[e] = P->in[8][(size_t)(l * 2 + 0) * RWC + 1024 + c]; mvn[e] = P->in[8][(size_t)(l * 2 + 1) * RWC + 1024 + c]; }
    for (int it = blockIdx.x; it < NT / 64; it += gridDim.x) {
        const size_t tok0 = (size_t)it * 64;
        __syncthreads();
        { const size_t token = tok0 + s_; const int t = (int)(token & (TSEQ - 1));
          const float* mgp = mgp0; asm volatile("" : "+v"(mgp)); const float* mgn = mgp + RWC;
#pragma unroll
          for (int hf = 0; hf < 2; ++hf) {
              const u16* p = PRW + token * RWC + 1792 + 16 * g_ + 8 * hf;
              const u32x4 wc = *(const u32x4*)p; u32x4 wp = {0u, 0u, 0u, 0u}, wn = {0u, 0u, 0u, 0u};
              if (t > 0) wp = *(const u32x4*)(p - RWC); if (t < TSEQ - 1) wn = *(const u32x4*)(p + RWC);
              float c[8], pv[8], nx[8], x[8]; unpack8(wc, c); unpack8(wp, pv); unpack8(wn, nx);
#pragma unroll
              for (int e = 0; e < 8; ++e) { const float xs = c[e] + mgp[8 * hf + e] * (pv[e] - c[e]) + mgn[8 * hf + e] * (nx[e] - c[e]); x[e] = fsig(xs); }
              *(u32x4*)(GS + s_ * 136 + 16 * g_ + 8 * hf) = pack8(x);
          } }
        __syncthreads();
        { f32x16 acc[2][2];
#pragma unroll
          for (int mb = 0; mb < 2; ++mb)
#pragma unroll
              for (int nb = 0; nb < 2; ++nb) acc[mb][nb] = f32x16{};
          const u16* gup = gup0; asm volatile("" : "+v"(gup));
#pragma unroll
          for (int ks = 0; ks < 8; ++ks) {
              const bf16x8 b0 = *reinterpret_cast<const bf16x8*>(gup + 16 * ks), b1 = *reinterpret_cast<const bf16x8*>(gup + 32 * 128 + 16 * ks);
#pragma unroll
              for (int mb = 0; mb < 2; ++mb) { const bf16x8 a = *reinterpret_cast<const bf16x8*>(GS + (32 * mb + r32) * 136 + 16 * ks + 8 * hi);
                  acc[mb][0] = __builtin_amdgcn_mfma_f32_32x32x16_bf16(a, b0, acc[mb][0], 0, 0, 0); acc[mb][1] = __builtin_amdgcn_mfma_f32_32x32x16_bf16(a, b1, acc[mb][1], 0, 0, 0); } }
#pragma unroll
          for (int mb = 0; mb < 2; ++mb)
#pragma unroll
              for (int nb = 0; nb < 2; ++nb)
#pragma unroll
                  for (int i = 0; i < 16; ++i) G[(32 * mb + crow(i, hi)) * 68 + 32 * nb + r32] = acc[mb][nb][i]; }
        asm volatile("s_waitcnt lgkmcnt(0)" ::: "memory");
#pragma unroll 2
        for (int q = 0; q < 8; ++q) {
            const int srow = 8 * q + ls; const size_t token = tok0 + srow; const int t = (int)(token & (TSEQ - 1));
            const u32x4 wo0 = *(const u32x4*)(Y + token * DM + 64 * h + 8 * lg), wo1 = *(const u32x4*)(Y + token * DM + 512 + 64 * h + 8 * lg);
            const u32x4 yda = *(const u32x4*)(PDA + token * DAC + 64 * h + 8 * lg);
            const u16* pvp = PRW + token * RWC + 1024 + 64 * h + 8 * lg;
            const u32x4 wc = *(const u32x4*)pvp; u32x4 wp = {0u, 0u, 0u, 0u}, wn = {0u, 0u, 0u, 0u};
            if (t > 0) wp = *(const u32x4*)(pvp - RWC); if (t < TSEQ - 1) wn = *(const u32x4*)(pvp + RWC);
            const float rk = RK[token * 8 + h] + RK[((size_t)NT + token) * 8 + h];
            const f32x4 g0 = *(const f32x4*)(G + srow * 68 + 8 * lg), g1 = *(const f32x4*)(G + srow * 68 + 8 * lg + 4);
            float o0[8], o1[8], vc[8], vp[8], vn[8], x[8], y[8]; unpack8(wo0, o0); unpack8(wo1, o1); unpack8(wc, vc); unpack8(wp, vp); unpack8(wn, vn);
            float sm = 0.f;
#pragma unroll
            for (int e = 0; e < 8; ++e) { x[e] = o0[e] + o1[e]; sm += x[e]; }
            sm += __shfl_xor(sm, 1); sm += __shfl_xor(sm, 2); sm += __shfl_xor(sm, 4);
            const float mu = sm * (1.f / 64.f); float sq = 0.f;
#pragma unroll
            for (int e = 0; e < 8; ++e) { x[e] -= mu; sq += x[e] * x[e]; }
            sq += __shfl_xor(sq, 1); sq += __shfl_xor(sq, 2); sq += __shfl_xor(sq, 4);
            const float rs = 1.0f / sqrtf(sq * (1.f / 64.f) + GN_EPS_);
#pragma unroll
            for (int e = 0; e < 8; ++e) { const float vs = vc[e] + mvp[e] * (vp[e] - vc[e]) + mvn[e] * (vn[e] - vc[e]); const float gg = e < 4 ? g0[e] : g1[e - 4];
                y[e] = (x[e] * rs * gng[e] + gnb[e] + rk * vs) * gg; }
            *(u32x4*)(Y + token * DM + 64 * h + 8 * lg) = pack8(y); *(u32x4*)(Y + token * DM + 512 + 64 * h + 8 * lg) = yda;
        }
    }
}

#define LP launder_kp(P)
__global__ void __launch_bounds__(512, 2) fwd_megakernel(Params Praw) {
    extern __shared__ __attribute__((aligned(16))) unsigned char shm[];
    cg::grid_group grid = cg::this_grid();
    KP P = (KP)__builtin_amdgcn_kernarg_segment_ptr();
    unsigned char* ws = LP->ws;
    float* X = LP->out; u16* XB = (u16*)(ws + WS_XB); u16* HB = (u16*)(ws + WS_BIG);
    phase0(LP, shm);
    grid.sync();
    for (int l = 0; l < DEPTH_; ++l) {
        { EpiSwiglu E; E.H = HB; run_gemm(shm, XB, (const u16*)(ws + WS_WGU) + (size_t)(l * 2 + 0) * NGU * DM, NGU, DM, E); }
        grid.sync();
        { EpiResid E; E.X = X; E.scale = 0.5f; E.S0 = l == 0 ? LP->in[0] : X; E.S1 = l == 0 ? LP->in[1] : X; E.SB = l == 0 ? nullptr : XB; run_gemm(shm, HB, (const u16*)(ws + WS_WDN) + (size_t)(l * 2 + 0) * DM * DFF, DM, DFF, E); }
        grid.sync();
        ln_phase<0>(X, XB, LP->in[2] + (l * 3 + 0) * DM, LP->in[3] + (l * 3 + 0) * DM);
        grid.sync();
        { EpiProj E; E.PRW = (u16*)(ws + WS_PRW); E.PDA = (u16*)(ws + WS_PDA); E.rt = (const float*)(ws + WS_ROPE); run_gemm(shm, XB, (const u16*)(ws + WS_WIN) + (size_t)l * NINP * DM, NINP, DM, E); }
        grid.sync();
        scan_phase(LP, l, shm);
        attn_phase(LP, l, shm);
        grid.sync();
#ifndef NO_POST
        post_phase(LP, l, shm);
#endif
        grid.sync();
        { EpiResid E; E.X = X; E.scale = 1.0f; E.S0 = X; E.S1 = X; E.SB = nullptr; run_gemm(shm, XB, (const u16*)(ws + WS_WOUT) + (size_t)l * DM * DM, DM, DM, E); }
        grid.sync();
        ln_phase<1>(X, XB, LP->in[2] + (l * 3 + 1) * DM, LP->in[3] + (l * 3 + 1) * DM);
        grid.sync();
        { EpiSwiglu E; E.H = HB; run_gemm(shm, XB, (const u16*)(ws + WS_WGU) + (size_t)(l * 2 + 1) * NGU * DM, NGU, DM, E); }
        grid.sync();
        { EpiResid E; E.X = X; E.scale = 0.5f; E.S0 = X; E.S1 = X; E.SB = XB; run_gemm(shm, HB, (const u16*)(ws + WS_WDN) + (size_t)(l * 2 + 1) * DM * DFF, DM, DFF, E); }
        grid.sync();
        if (l == DEPTH_ - 1) ln_phase<2>(X, XB, LP->in[2] + (l * 3 + 2) * DM, LP->in[3] + (l * 3 + 2) * DM);
        else ln_phase<1>(X, XB, LP->in[2] + (l * 3 + 2) * DM, LP->in[3] + (l * 3 + 2) * DM);
        grid.sync();
    }
}

extern "C" void kernel_launch(void* const* d_in, const int* in_sizes, int n_in, void* d_out, int out_size, void* d_ws, size_t ws_size, hipStream_t stream) {
    static int grid_blocks = 0;
    if (!grid_blocks) {
        int dev = 0, cus = 0, per_cu = 0;
        (void)hipGetDevice(&dev);
        (void)hipDeviceGetAttribute(&cus, hipDeviceAttributeMultiprocessorCount, dev);
        if (hipFuncSetAttribute((const void*)fwd_megakernel, hipFuncAttributeMaxDynamicSharedMemorySize, LDS_BYTES) != hipSuccess) fprintf(stderr, "kernel_launch: hipFuncSetAttribute failed\n");
        (void)hipOccupancyMaxActiveBlocksPerMultiprocessor(&per_cu, (const void*)fwd_megakernel, 512, LDS_BYTES);
        if (per_cu < 1) per_cu = 1;
        grid_blocks = cus * per_cu;
        if (grid_blocks > 256) grid_blocks = 256;
        if (n_in != 21 || ws_size < WS_END) fprintf(stderr, "kernel_launch: unexpected n_in %d / ws_size %zu (need %zu)\n", n_in, ws_size, (size_t)WS_END);
    }
    Params p{};
    for (int i = 0; i < 21; ++i) p.in[i] = (const float*)d_in[i];
    p.out = (float*)d_out; p.ws = (unsigned char*)d_ws;
    for (int i = 0; i < 32; ++i) p.inv[i] = powf(10000.0f, -(float)(2 * i) / 64.0f);
    void* args[] = {&p};
    hipError_t e = hipLaunchCooperativeKernel((const void*)fwd_megakernel, dim3(grid_blocks), dim3(512), args, LDS_BYTES, stream);
    if (e != hipSuccess) fprintf(stderr, "cooperative launch failed: %s (grid %d)\n", hipGetErrorString(e), grid_blocks);
}
#ifdef TESTK
__global__ void __launch_bounds__(512, 2) tk_phase0(Params Praw) { KP P = (KP)__builtin_amdgcn_kernarg_segment_ptr(); extern __shared__ __attribute__((aligned(16))) unsigned char shm[]; phase0(P, shm); }
__global__ void __launch_bounds__(512, 2) tk_gemm_swiglu(Params Praw) { KP P = (KP)__builtin_amdgcn_kernarg_segment_ptr(); extern __shared__ __attribute__((aligned(16))) unsigned char shm[]; EpiSwiglu E; E.H = (u16*)P->ws; run_gemm(shm, (u16*)P->ws, (const u16*)P->ws, NGU, DM, E); }
__global__ void __launch_bounds__(512, 2) tk_gemm_resid(Params Praw) { KP P = (KP)__builtin_amdgcn_kernarg_segment_ptr(); extern __shared__ __attribute__((aligned(16))) unsigned char shm[]; EpiResid E; E.X = P->out; E.scale = 0.5f; run_gemm(shm, (u16*)P->ws, (const u16*)P->ws, DM, DFF, E); }
__global__ void __launch_bounds__(512, 2) tk_gemm_proj(Params Praw) { KP P = (KP)__builtin_amdgcn_kernarg_segment_ptr(); extern __shared__ __attribute__((aligned(16))) unsigned char shm[]; EpiProj E; E.PRW = (u16*)P->ws; E.PDA = (u16*)P->ws; run_gemm(shm, (u16*)P->ws, (const u16*)P->ws, NINP, DM, E); }
__global__ void __launch_bounds__(512, 2) tk_ln(Params Praw) { KP P = (KP)__builtin_amdgcn_kernarg_segment_ptr(); ln_phase<0>(P->out, (u16*)P->ws, P->in[2], P->in[3]); }
__global__ void __launch_bounds__(512, 2) tk_rope(Params Praw) { KP P = (KP)__builtin_amdgcn_kernarg_segment_ptr(); rope_phase((u16*)P->ws, (const float*)P->ws); }
__global__ void __launch_bounds__(512, 2) tk_attn(Params Praw) { KP P = (KP)__builtin_amdgcn_kernarg_segment_ptr(); extern __shared__ __attribute__((aligned(16))) unsigned char shm[]; attn_phase(P, 1, shm); }
__global__ void __launch_bounds__(512, 2) tk_scan(Params Praw) { KP P = (KP)__builtin_amdgcn_kernarg_segment_ptr(); extern __shared__ __attribute__((aligned(16))) unsigned char shm[]; scan_phase(P, 1, shm); }
__global__ void __launch_bounds__(512, 2) tk_post(Params Praw) { KP P = (KP)__builtin_amdgcn_kernarg_segment_ptr(); extern __shared__ __attribute__((aligned(16))) unsigned char shm[]; post_phase(P, 1, shm); }
#endif
#ifdef TESTK
__global__ void __launch_bounds__(512, 2) tk_attn_pass_only(Params Praw) { KP P = (KP)__builtin_amdgcn_kernarg_segment_ptr(); extern __shared__ __attribute__((aligned(16))) unsigned char shm[];
  f32x16 o[4]; float l_reg; const u16* PDA = (const u16*)P->ws;
  att::attn_pass(PDA + blockIdx.x * 1000, PDA + 512, PDA + 1024, (char*)shm, o, l_reg);
  float* out = P->out + threadIdx.x * 65;
  for (int d = 0; d < 4; ++d) for (int r = 0; r < 16; ++r) out[d * 16 + r] = o[d][r] * l_reg;
}
#endif
```
